# Optimizing an MI355X kernel written in HIP

```python
import jax, jax.numpy as jnp
from jax import lax
import numpy as np

D_MODEL = 1024
BATCH = 16
SEQ = 4096
DEPTH = 4

CHUNK = 64
Q_BLOCK = 128
MEM_LEN = 256
NORM_EPS = 1e-6

MIX_WIDTH = D_MODEL
MLA_WIDTH = MIX_WIDTH // 2
RWKV_WIDTH = MIX_WIDTH - MLA_WIDTH

MLA_HEADS = 8
MLA_V_DIM = MLA_WIDTH // MLA_HEADS
MLA_NOPE_DIM = MLA_V_DIM
MLA_ROPE_DIM = MLA_NOPE_DIM // 2
MLA_Q_RANK = 3 * D_MODEL // 16
MLA_KV_RANK = D_MODEL // 8
ROPE_THETA = 10000.0

RWKV_HEAD = 64
RWKV_HEADS = RWKV_WIDTH // RWKV_HEAD
DECAY_RANK = 32
ICL_RANK = 32
GATE_RANK = 96
VRES_RANK = 32
GN_EPS = 64e-5

CA_HEADS = 4
CA_HEAD_DIM = D_MODEL // CA_HEADS
D_FF = 4 * D_MODEL

MLA_COLS = MLA_Q_RANK + MLA_KV_RANK + MLA_ROPE_DIM
RWKV_COLS0 = 3 * RWKV_WIDTH + DECAY_RANK + ICL_RANK + GATE_RANK
RWKV_COLS = RWKV_COLS0 + VRES_RANK
IN_COLS0 = MLA_COLS + RWKV_COLS0
IN_COLS = MLA_COLS + RWKV_COLS

kernel_name = "hybrid_mla_rwkv7_stream_encoder"


def rms_norm(x, g, eps=NORM_EPS):
    xf = x.astype(jnp.float32)
    y = xf * lax.rsqrt(jnp.mean(xf * xf, axis=-1, keepdims=True) + eps)
    return (y * g.astype(jnp.float32)).astype(x.dtype)


def rope_tables(positions):
    inv = ROPE_THETA ** (-jnp.arange(0, MLA_ROPE_DIM, 2, dtype=jnp.float32) / MLA_ROPE_DIM)
    ang = positions.astype(jnp.float32)[..., None] * inv
    return jnp.cos(ang), jnp.sin(ang)


def apply_rope(x, cos, sin):
    x1, x2 = jnp.split(x.astype(jnp.float32), 2, axis=-1)
    return jnp.concatenate([x1 * cos - x2 * sin, x1 * sin + x2 * cos], axis=-1).astype(x.dtype)


def token_shift(z, mu):
    prev = jnp.pad(z, ((0, 0), (1, 0), (0, 0)))[:, :-1]
    return z + (prev - z) * mu


def chunk_causal_mla_attention(q_nope, q_rope, k_nope, k_rope, v):
    B_, S_, H, _ = q_nope.shape
    nb = S_ // Q_BLOCK
    scale = (MLA_NOPE_DIM + MLA_ROPE_DIM) ** -0.5
    key_chunk = jnp.arange(S_) // CHUNK

    def to_blocks(t):
        return jnp.moveaxis(t.reshape(B_, nb, Q_BLOCK, *t.shape[2:]), 1, 0)

    def block(args):
        qn, qr, start = args
        s = (jnp.einsum('bqhd,bkhd->bhqk', qn, k_nope, preferred_element_type=jnp.float32)
             + jnp.einsum('bqhr,bkr->bhqk', qr, k_rope, preferred_element_type=jnp.float32)) * scale
        q_chunk = (start + jnp.arange(Q_BLOCK)) // CHUNK
        s = jnp.where(key_chunk[None, :] <= q_chunk[:, None], s, -jnp.inf)
        p = jax.nn.softmax(s, axis=-1).astype(v.dtype)
        return jnp.einsum('bhqk,bkhd->bqhd', p, v)

    out = lax.map(block, (to_blocks(q_nope), to_blocks(q_rope), jnp.arange(nb) * Q_BLOCK))
    return jnp.moveaxis(out, 0, 1).reshape(B_, S_, H, v.shape[-1])


def mla_group(cols, cos, sin, q_norm, w_uq, kv_norm, w_ukv, out_norm):
    B_, S_, _ = cols.shape
    c_q = cols[..., :MLA_Q_RANK]
    c_kv = cols[..., MLA_Q_RANK:MLA_Q_RANK + MLA_KV_RANK]
    k_rope = cols[..., MLA_Q_RANK + MLA_KV_RANK:]
    q = (rms_norm(c_q, q_norm) @ w_uq).reshape(B_, S_, MLA_HEADS, MLA_NOPE_DIM + MLA_ROPE_DIM)
    q_nope = q[..., :MLA_NOPE_DIM]
    q_rope = apply_rope(q[..., MLA_NOPE_DIM:], cos[:, :, None], sin[:, :, None])
    k_rope = apply_rope(k_rope, cos, sin)
    kv = (rms_norm(c_kv, kv_norm) @ w_ukv).reshape(B_, S_, MLA_HEADS, MLA_NOPE_DIM + MLA_V_DIM)
    k_nope, v = kv[..., :MLA_NOPE_DIM], kv[..., MLA_NOPE_DIM:]
    o = chunk_causal_mla_attention(q_nope, q_rope, k_nope, k_rope, v)
    o = rms_norm(o, out_norm.reshape(MLA_HEADS, MLA_V_DIM))
    return o.reshape(B_, S_, MLA_WIDTH)


def wkv7(r, decay, k, v, a, b):
    B_, S_, H, N = r.shape
    xs = tuple(jnp.swapaxes(t.astype(jnp.float32), 0, 1) for t in (r, decay, k, v, a, b))

    def step(state, inp):
        rt, wt, kt, vt, at, bt = inp
        sa = jnp.einsum('bhvk,bhk->bhv', state, at)
        state = state * wt[:, :, None, :] + sa[..., None] * bt[:, :, None, :] + vt[..., None] * kt[:, :, None, :]
        return state, jnp.einsum('bhvk,bhk->bhv', state, rt)

    s0 = jnp.zeros((B_, H, N, N), jnp.float32)
    _, ys = lax.scan(step, s0, xs)
    return jnp.swapaxes(ys, 0, 1)


def rwkv7_group(cols, w0, w2, a0, a2, g2, k_k, k_a, r_k, ln_w, ln_b, v_first, v0, v2):
    B_, S_, _ = cols.shape
    RW, H, N = RWKV_WIDTH, RWKV_HEADS, RWKV_HEAD
    r = cols[..., :RW]
    k = cols[..., RW:2 * RW]
    v = cols[..., 2 * RW:3 * RW]
    o = 3 * RW
    w_l = cols[..., o:o + DECAY_RANK]
    o += DECAY_RANK
    a_l = cols[..., o:o + ICL_RANK]
    o += ICL_RANK
    g_l = cols[..., o:o + GATE_RANK]
    o += GATE_RANK

    w_log = -jax.nn.softplus(-(w0 + jnp.tanh(w_l) @ w2)) - 0.5
    decay = jnp.exp(-jnp.exp(w_log.astype(jnp.float32)))
    a = jax.nn.sigmoid(a0 + a_l @ a2)
    g = jax.nn.sigmoid(g_l) @ g2
    if v0 is None:
        v_first = v
    else:
        v_l = cols[..., o:o + VRES_RANK]
        v = v + (v_first - v) * jax.nn.sigmoid(v0 + v_l @ v2)

    heads = lambda t: t.reshape(B_, S_, H, N)
    kk = heads(k * k_k).astype(jnp.float32)
    kk = kk / jnp.maximum(jnp.sqrt(jnp.sum(kk * kk, axis=-1, keepdims=True)), 1e-12)
    k = k * (1.0 + (a - 1.0) * k_a)
    rh, kh, vh, ah = heads(r), heads(k), heads(v), heads(a)
    y = wkv7(rh, heads(decay), kh, vh, -kk, kk * ah)

    mu = jnp.mean(y, axis=-1, keepdims=True)
    var = jnp.mean(jnp.square(y - mu), axis=-1, keepdims=True)
    y = (y - mu) * lax.rsqrt(var + GN_EPS) * ln_w.reshape(H, N) + ln_b.reshape(H, N)
    y = y + jnp.sum(rh * kh * r_k, axis=-1, keepdims=True) * vh
    out = (y.reshape(B_, S_, RW) * g).astype(cols.dtype)
    return out, v_first


def mem_cross_attention(hn, mem_n, wq, wkv, wo):
    B_, S_, _ = hn.shape
    M = mem_n.shape[1]
    q = (hn @ wq).reshape(B_, S_, CA_HEADS, CA_HEAD_DIM)
    kv = (mem_n @ wkv).reshape(B_, M, 2, CA_HEADS, CA_HEAD_DIM)
    k, v = kv[:, :, 0], kv[:, :, 1]
    s = jnp.einsum('bshd,bmhd->bhsm', q, k, preferred_element_type=jnp.float32) * (CA_HEAD_DIM ** -0.5)
    p = jax.nn.softmax(s, axis=-1).astype(v.dtype)
    o = jnp.einsum('bhsm,bmhd->bshd', p, v).reshape(B_, S_, D_MODEL)
    return o @ wo


def squared_relu_mlp(hn, w_up, w_down):
    return jnp.square(jax.nn.relu(hn @ w_up)) @ w_down


def setup_inputs(seed: int = 0) -> dict:
    key = jax.random.key(seed)
    keys = iter(jax.random.split(key, 64))
    f32 = jnp.float32

    def nrm(shape, scale):
        return scale * jax.random.normal(next(keys), shape, f32)

    def gain(shape):
        return 1.0 + nrm(shape, 0.02)

    L, L1 = DEPTH, DEPTH - 1
    RW = RWKV_WIDTH
    x = jax.random.normal(next(keys), (BATCH, SEQ, D_MODEL), f32)
    mem = jax.random.normal(next(keys), (BATCH, MEM_LEN, D_MODEL), f32)
    start = jax.random.randint(next(keys), (BATCH, 1), 0, 64) * CHUNK
    positions = (start + jnp.arange(SEQ)[None, :]).astype(jnp.int32)

    n = jnp.arange(RW, dtype=f32) / (RW - 1)
    decay_speed = -7.0 + 5.0 * n ** 0.85 + 0.5
    w0 = decay_speed[None, :] + nrm((L, RW), 0.1)

    return {
        "x": x,
        "mem": mem,
        "positions": positions,
        "mix_norm": gain((L, D_MODEL)),
        "w_in_first": nrm((D_MODEL, IN_COLS0), D_MODEL ** -0.5),
        "w_in_rest": nrm((L1, D_MODEL, IN_COLS), D_MODEL ** -0.5),
        "shift_mu_first": jax.random.uniform(next(keys), (RWKV_COLS0,), f32, 0.2, 0.8),
        "shift_mu_rest": jax.random.uniform(next(keys), (L1, RWKV_COLS), f32, 0.2, 0.8),
        "mla_q_norm": gain((L, MLA_Q_RANK)),
        "mla_w_uq": nrm((L, MLA_Q_RANK, MLA_HEADS * (MLA_NOPE_DIM + MLA_ROPE_DIM)), MLA_Q_RANK ** -0.5),
        "mla_kv_norm": gain((L, MLA_KV_RANK)),
        "mla_w_ukv": nrm((L, MLA_KV_RANK, MLA_HEADS * (MLA_NOPE_DIM + MLA_V_DIM)), MLA_KV_RANK ** -0.5),
        "mla_out_norm": gain((L, MLA_WIDTH)),
        "rwkv_w0": w0,
        "rwkv_w2": nrm((L, DECAY_RANK, RW), 0.1 * DECAY_RANK ** -0.5),
        "rwkv_a0": nrm((L, RW), 0.1),
        "rwkv_a2": nrm((L, ICL_RANK, RW), 0.5 * ICL_RANK ** -0.5),
        "rwkv_g2": nrm((L, GATE_RANK, RW), GATE_RANK ** -0.5),
        "rwkv_v0": 1.0 + nrm((L1, RW), 0.1),
        "rwkv_v2": nrm((L1, VRES_RANK, RW), 0.5 * VRES_RANK ** -0.5),
        "rwkv_k_k": 0.85 + nrm((L, RW), 0.02),
        "rwkv_k_a": 1.0 + nrm((L, RW), 0.02),
        "rwkv_r_k": nrm((L, RWKV_HEADS, RWKV_HEAD), 0.1),
        "rwkv_ln_w": gain((L, RW)),
        "rwkv_ln_b": nrm((L, RW), 0.02),
        "w_out": nrm((L, MIX_WIDTH, D_MODEL), MIX_WIDTH ** -0.5),
        "ca_norm": gain((L, D_MODEL)),
        "mem_norm": gain((D_MODEL,)),
        "ca_wq": nrm((L, D_MODEL, D_MODEL), D_MODEL ** -0.5),
        "ca_wkv": nrm((L, D_MODEL, 2 * D_MODEL), D_MODEL ** -0.5),
        "ca_wo": nrm((L, D_MODEL, D_MODEL), D_MODEL ** -0.5),
        "mlp_norm": gain((L, D_MODEL)),
        "mlp_w_up": nrm((L, D_MODEL, D_FF), D_MODEL ** -0.5),
        "mlp_w_down": nrm((L, D_FF, D_MODEL), D_FF ** -0.5),
        "final_norm": gain((D_MODEL,)),
    }


def reference(x, mem, positions, mix_norm, w_in_first, w_in_rest, shift_mu_first, shift_mu_rest,
              mla_q_norm, mla_w_uq, mla_kv_norm, mla_w_ukv, mla_out_norm,
              rwkv_w0, rwkv_w2, rwkv_a0, rwkv_a2, rwkv_g2, rwkv_v0, rwkv_v2,
              rwkv_k_k, rwkv_k_a, rwkv_r_k, rwkv_ln_w, rwkv_ln_b, w_out,
              ca_norm, mem_norm, ca_wq, ca_wkv, ca_wo,
              mlp_norm, mlp_w_up, mlp_w_down, final_norm):
    cos, sin = rope_tables(positions)
    mem_n = rms_norm(mem, mem_norm)
    h = x
    v_first = None
    for l in range(DEPTH):
        if l == 0:
            w_in, mu, v0, v2 = w_in_first, shift_mu_first, None, None
        else:
            w_in, mu, v0, v2 = w_in_rest[l - 1], shift_mu_rest[l - 1], rwkv_v0[l - 1], rwkv_v2[l - 1]
        proj = rms_norm(h, mix_norm[l]) @ w_in
        att = mla_group(proj[..., :MLA_COLS], cos, sin, mla_q_norm[l], mla_w_uq[l],
                        mla_kv_norm[l], mla_w_ukv[l], mla_out_norm[l])
        rw, v_first = rwkv7_group(token_shift(proj[..., MLA_COLS:], mu),
                                  rwkv_w0[l], rwkv_w2[l], rwkv_a0[l], rwkv_a2[l], rwkv_g2[l],
                                  rwkv_k_k[l], rwkv_k_a[l], rwkv_r_k[l], rwkv_ln_w[l], rwkv_ln_b[l],
                                  v_first, v0, v2)
        h = h + jnp.concatenate([att, rw], axis=-1) @ w_out[l]
        h = h + mem_cross_attention(rms_norm(h, ca_norm[l]), mem_n, ca_wq[l], ca_wkv[l], ca_wo[l])
        h = h + squared_relu_mlp(rms_norm(h, mlp_norm[l]), mlp_w_up[l], mlp_w_down[l])
    return rms_norm(h, final_norm)
```

```cpp
#include <hip/hip_runtime.h>
#include <hip/hip_cooperative_groups.h>
#include <cstdint>
#include <cstdio>
namespace cg = cooperative_groups;
namespace pg8 {
#define PG8_LAS __attribute__((address_space(3)))
typedef unsigned short bf16_t;
typedef short bf16x8 __attribute__((ext_vector_type(8)));
typedef float f32x4 __attribute__((ext_vector_type(4)));
typedef unsigned u32x4 __attribute__((ext_vector_type(4)));
constexpr int BM = 256, BK = 64, HALF = 128, HTB = HALF * BK * 2  , STAGE_BYTES = 8 * HTB, NXCD = 8, WGM = 8;

__host__ __device__ __forceinline__ int lds_byte(int r, int c) { const int st = (r >> 4) * 2 + (c >> 5), rr = r & 15, cc = c & 31, ob = rr * 64 + cc * 2; return st * 1024 + (ob ^ (((ob >> 9) & 1) << 5)); }
__host__ __device__ __forceinline__ void stage_rc(int b, int& R, int& C) { const int st = b / 1024, sb = b % 1024, swz = sb ^ (((sb >> 9) & 1) << 5); R = (st >> 1) * 16 + swz / 64; C = (st & 1) * 32 + (swz % 64) / 2; }
__host__ __device__ __forceinline__ int perm32(int rho) { const int n = rho >> 4, i = rho & 15; return 8 * (i >> 2) + 4 * n + (i & 3); }

struct Unit { int pm, pn; };

struct StaticOrder {
    int nM, nN, nwg, G, c;
    __host__ __device__ void init(int M, int N, int G_, int c_) { nM = M / BM; nN = N / BM; nwg = nM * nN; G = G_; c = c_; }
    __host__ __device__ bool next(int i, Unit& u) const {
        const long L = (long)i * G + c; if (L >= nwg) return false;
        int wgid = (int)L; { const int q = nwg / NXCD, r = nwg % NXCD, xcd = wgid % NXCD, off = wgid / NXCD; wgid = (xcd < r ? xcd * (q + 1) : r * (q + 1) + (xcd - r) * q) + off; }
        const int nig = WGM * nN, gid = wgid / nig, fm = gid * WGM, gsz = (nM - fm) < WGM ? (nM - fm) : WGM;
        u.pm = fm + ((wgid % nig) % gsz); u.pn = (wgid % nig) / gsz; return true;
    }
    __device__ __forceinline__ void a_ready(const Unit&) const {}
    __device__ __forceinline__ void done(const Unit&) const {}
};

struct Gemm { const bf16_t* A; const bf16_t* Bt; int M, N, K, lda, ldb; long a_hi, a_lo, a_pn, b_pn, b_bt, b_pmo; int a_d, tpb, b_pmod;
    __device__ __forceinline__ const char* uA(const Unit& u) const { return (const char*)A + (size_t)(u.pm / a_d) * a_hi + (size_t)(u.pm % a_d) * a_lo + (size_t)u.pn * a_pn; }
    __device__ __forceinline__ const char* uB(const Unit& u) const { return (const char*)Bt + (size_t)u.pn * b_pn + (size_t)(u.pm / tpb) * b_bt + (size_t)(u.pm % b_pmod) * b_pmo; } };
__device__ __forceinline__ Gemm mk_gemm(const bf16_t* A, const bf16_t* Bt, int M, int N, int K) { Gemm g; g.A = A; g.Bt = Bt; g.M = M; g.N = N; g.K = K; g.lda = K; g.ldb = K; g.a_hi = 0; g.a_lo = (long)512 * K; g.a_d = 1 << 30; g.a_pn = 0;
    g.b_pn = (long)512 * K; g.b_bt = 0; g.tpb = 1 << 30; g.b_pmo = 0; g.b_pmod = 1; return g; }

__device__ __forceinline__ unsigned cvt_pk_bf16(float lo, float hi) { unsigned r; asm volatile("v_cvt_pk_bf16_f32 %0, %1, %2" : "=v"(r) : "v"(lo), "v"(hi)); return r; }
typedef float f32x2 __attribute__((ext_vector_type(2)));
typedef unsigned u32x2 __attribute__((ext_vector_type(2)));

__constant__ float ROPE_INV[16] = {1.000000000e+00f, 5.623413252e-01f, 3.162277660e-01f, 1.778279410e-01f, 1.000000000e-01f, 5.623413252e-02f, 3.162277660e-02f, 1.778279410e-02f,
                                   1.000000000e-02f, 5.623413252e-03f, 3.162277660e-03f, 1.778279410e-03f, 1.000000000e-03f, 5.623413252e-04f, 3.162277660e-04f, 1.778279410e-04f};
__device__ __forceinline__ void rope_cs(int pos, int i, float& c, float& s) {
    double t = (double)pos * (double)ROPE_INV[i] * 0.15915494309189535;
    t -= __builtin_rint(t);
    const float tf = (float)t;
    c = __builtin_amdgcn_cosf(tf); s = __builtin_amdgcn_sinf(tf);
}
__device__ __forceinline__ float sigmoidf_(float x) { return 1.0f / (1.0f + __expf(-x)); }

template <int ACT> struct EpiBf16 {
    static constexpr bool PERM = true, AFTER_DRAIN = false;
    bf16_t* O; long ldc; float scale; int c2_lo, c2_hi; bf16_t* O2; long ldc2; const float* ss;
    __device__ __forceinline__ void operator()(const f32x4 (&acc)[2][2][4][2], const Unit& u, int wr, int wc, int fr, int fq) const {
        const int row0 = u.pm * BM + wr * 64 + fr; const int col0 = u.pn * BM + wc * 32 + 8 * fq;
#pragma unroll
        for (int ai = 0; ai < 2; ++ai)
#pragma unroll
            for (int m = 0; m < 4; ++m) { const long row = row0 + ai * HALF + m * 16; float rsc = scale; if (ss) { const f32x4* pp = (const f32x4*)(ss + row * 16); const f32x4 a0 = pp[0], a1 = pp[1], a2 = pp[2], a3 = pp[3]; const f32x4 t = (a0 + a1) + (a2 + a3); rsc = scale * (1.0f / sqrtf(((t[0] + t[1]) + (t[2] + t[3])) * (1.0f / 1024.0f) + 1e-6f)); }
#pragma unroll
                for (int bj = 0; bj < 2; ++bj) { f32x4 v0 = acc[ai][bj][m][0] * rsc, v1 = acc[ai][bj][m][1] * rsc; const int col = col0 + bj * HALF;
                    if (ACT == 1) {
#pragma unroll
                        for (int j = 0; j < 4; ++j) { float a = fmaxf(v0[j], 0.f), b = fmaxf(v1[j], 0.f); v0[j] = a * a; v1[j] = b * b; } }
                    u32x4 w; w.x = cvt_pk_bf16(v0[0], v0[1]); w.y = cvt_pk_bf16(v0[2], v0[3]); w.z = cvt_pk_bf16(v1[0], v1[1]); w.w = cvt_pk_bf16(v1[2], v1[3]);
                    if (col < c2_lo) *(u32x4*)(O + row * ldc + col) = w;
                    else if (col < c2_hi) *(u32x4*)(O2 + row * ldc2 + (col - c2_lo)) = w; } }
    }
};
__device__ __forceinline__ EpiBf16<0> mk_epi_bf16(bf16_t* O, long ldc, float scale) { EpiBf16<0> e; e.O = O; e.ldc = ldc; e.scale = scale; e.c2_lo = 1 << 30; e.c2_hi = 1 << 30; e.O2 = O; e.ldc2 = 0; e.ss = nullptr; return e; }


struct EpiVT {
    static constexpr bool PERM = true, AFTER_DRAIN = false;
    bf16_t* O;
    __device__ __forceinline__ void operator()(const f32x4 (&acc)[2][2][4][2], const Unit& u, int wr, int wc, int fr, int fq) const {
        const int row0 = u.pm * BM + wr * 64 + fr; const int col0 = u.pn * BM + wc * 32 + 8 * fq;
#pragma unroll
        for (int ai = 0; ai < 2; ++ai)
#pragma unroll
            for (int m = 0; m < 4; ++m) { const int f = row0 + ai * HALF + m * 16;
#pragma unroll
                for (int bj = 0; bj < 2; ++bj) { const f32x4 v0 = acc[ai][bj][m][0], v1 = acc[ai][bj][m][1]; const int tok = col0 + bj * HALF;
                    u32x4 w; w.x = cvt_pk_bf16(v0[0], v0[1]); w.y = cvt_pk_bf16(v0[2], v0[3]); w.z = cvt_pk_bf16(v1[0], v1[1]); w.w = cvt_pk_bf16(v1[2], v1[3]);
                    const size_t idx = ((size_t)(((tok >> 12) * 8 + (f >> 6)) * 64 + ((tok & 4095) >> 6)) << 12) + (size_t)((f & 63) * 64 + (tok & 63));
                    *(u32x4*)(O + idx) = w; } }
    }
};

struct EpiQRope {
    static constexpr bool PERM = false, AFTER_DRAIN = false;
    bf16_t* O; const int* pos; float scale;
    __device__ __forceinline__ void operator()(const f32x4 (&acc)[2][2][4][2], const Unit& u, int wr, int wc, int fr, int fq) const {
#pragma unroll
        for (int bj = 0; bj < 2; ++bj) { const int cbase = u.pn * BM + bj * HALF + wc * 32; const bool is_rope = ((cbase >> 5) % 3) == 2;
#pragma unroll
            for (int ai = 0; ai < 2; ++ai)
#pragma unroll
                for (int m = 0; m < 4; ++m) { const long row = u.pm * BM + ai * HALF + wr * 64 + m * 16 + fr; f32x4 v0 = acc[ai][bj][m][0], v1 = acc[ai][bj][m][1];
                    if (is_rope) { const int p = pos[row];
#pragma unroll
                        for (int j = 0; j < 4; ++j) { float c, s; rope_cs(p, 4 * fq + j, c, s); const float a = v0[j], b = v1[j]; v0[j] = a * c - b * s; v1[j] = a * s + b * c; } }
                    v0 = v0 * scale; v1 = v1 * scale;
                    u32x2 w0, w1; w0.x = cvt_pk_bf16(v0[0], v0[1]); w0.y = cvt_pk_bf16(v0[2], v0[3]); w1.x = cvt_pk_bf16(v1[0], v1[1]); w1.y = cvt_pk_bf16(v1[2], v1[3]);
                    bf16_t* p0 = O + row * 768 + cbase + 4 * fq; *(u32x2*)p0 = w0; *(u32x2*)(p0 + 16) = w1; } }
    }
};

struct EpiLowrank {
    static constexpr bool PERM = true, AFTER_DRAIN = false;
    bf16_t* O; const float* w0; const float* a0; const float* v0;
    __device__ __forceinline__ void operator()(const f32x4 (&acc)[2][2][4][2], const Unit& u, int wr, int wc, int fr, int fq) const {
        const int row0 = u.pm * BM + wr * 64 + fr; const int col0 = u.pn * BM + wc * 32 + 8 * fq; const int kind = u.pn >> 1;
#pragma unroll
        for (int bj = 0; bj < 2; ++bj) { const int col = col0 + bj * HALF; const int c5 = col & 511;
            float bias[8];
#pragma unroll
            for (int j = 0; j < 8; ++j) bias[j] = kind == 0 ? w0[c5 + j] : kind == 1 ? a0[c5 + j] : kind == 3 ? v0[c5 + j] : 0.f;
#pragma unroll
            for (int ai = 0; ai < 2; ++ai)
#pragma unroll
                for (int m = 0; m < 4; ++m) { const long row = row0 + ai * HALF + m * 16; float v[8];
#pragma unroll
                    for (int j = 0; j < 4; ++j) { v[j] = acc[ai][bj][m][0][j] + bias[j]; v[4 + j] = acc[ai][bj][m][1][j] + bias[4 + j]; }
#pragma unroll
                    for (int j = 0; j < 8; ++j) {
                        if (kind == 0) { v[j] = -0.87503877f * __builtin_amdgcn_rcpf(1.0f + __expf(-v[j])); }
                        else if (kind == 1 || kind == 3) v[j] = sigmoidf_(v[j]);
                    }
                    u32x4 w; w.x = cvt_pk_bf16(v[0], v[1]); w.y = cvt_pk_bf16(v[2], v[3]); w.z = cvt_pk_bf16(v[4], v[5]); w.w = cvt_pk_bf16(v[6], v[7]);
                    *(u32x4*)(O + row * 2048 + col) = w; } }
    }
};

template <bool BASE_F32, bool OUT_F32> struct EpiResidual {
    static constexpr bool PERM = false, AFTER_DRAIN = false;
    const float* basef; const bf16_t* baseh; float* outf; bf16_t* outh; float* ss;
    __device__ __forceinline__ void operator()(const f32x4 (&acc)[2][2][4][2], const Unit& u, int wr, int wc, int fr, int fq) const {
        asm volatile("" : "+v"(fr), "+v"(fq));
        const int lane = fq * 16 + fr; const int colb = u.pn * BM + wc * 32 + 4 * fq;
#pragma unroll
        for (int ai = 0; ai < 2; ++ai)
#pragma unroll
            for (int m = 0; m < 4; ++m) { const int row = u.pm * BM + ai * HALF + wr * 64 + m * 16 + fr; const size_t off = (size_t)row * 1024 + colb; float s = 0.f;
#pragma unroll
                for (int bj = 0; bj < 2; ++bj)
#pragma unroll
                    for (int n = 0; n < 2; ++n) { const size_t o = off + bj * HALF + n * 16; f32x4 b;
                        if (BASE_F32) b = *(const f32x4*)(basef + o);
                        else { const u32x2 w = *(const u32x2*)(baseh + o); b[0] = __builtin_bit_cast(float, w.x << 16); b[1] = __builtin_bit_cast(float, w.x & 0xffff0000u); b[2] = __builtin_bit_cast(float, w.y << 16); b[3] = __builtin_bit_cast(float, w.y & 0xffff0000u); }
                        const f32x4 v = b + acc[ai][bj][m][n];
                        s += (v[0] * v[0] + v[1] * v[1]) + (v[2] * v[2] + v[3] * v[3]);
                        if (OUT_F32) *(f32x4*)(outf + o) = v;
                        else { u32x2 w; w.x = cvt_pk_bf16(v[0], v[1]); w.y = cvt_pk_bf16(v[2], v[3]); *(u32x2*)(outh + o) = w; } }
                s += __builtin_bit_cast(float, __builtin_amdgcn_ds_bpermute((lane ^ 16) << 2, __builtin_bit_cast(int, s)));
                s += __builtin_bit_cast(float, __builtin_amdgcn_ds_bpermute((lane ^ 32) << 2, __builtin_bit_cast(int, s)));
                if (fq == 0) ss[(size_t)row * 16 + u.pn * 4 + wc] = s; }
    }
};

struct EpiSoftmax {
    static constexpr bool PERM = true, AFTER_DRAIN = false;
    bf16_t* P; PG8_LAS float* xm; PG8_LAS float* xs; const float* ss; float scale;
    __device__ __forceinline__ void operator()(const f32x4 (&acc_c)[2][2][4][2], const Unit& u, int wr, int wc, int fr, int fq) const {
        f32x4 (&acc)[2][2][4][2] = const_cast<f32x4 (&)[2][2][4][2]>(acc_c);
        asm volatile("" : "+v"(fr), "+v"(fq));
        const int lane = fq * 16 + fr;
#pragma unroll
        for (int ai = 0; ai < 2; ++ai)
#pragma unroll
            for (int m = 0; m < 4; ++m) { float mx = -INFINITY;
                const f32x4* pp = (const f32x4*)(ss + ((size_t)u.pm * BM + ai * HALF + wr * 64 + m * 16 + fr) * 16); const f32x4 t4 = (pp[0] + pp[1]) + (pp[2] + pp[3]);
                const float rsc = scale * (1.0f / sqrtf(((t4[0] + t4[1]) + (t4[2] + t4[3])) * (1.0f / 1024.0f) + 1e-6f));
#pragma unroll
                for (int bj = 0; bj < 2; ++bj)
#pragma unroll
                    for (int n = 0; n < 2; ++n) { const f32x4 v = acc[ai][bj][m][n] * rsc; acc[ai][bj][m][n] = v; mx = fmaxf(mx, fmaxf(fmaxf(v[0], v[1]), fmaxf(v[2], v[3]))); }
                mx = fmaxf(mx, __builtin_bit_cast(float, __builtin_amdgcn_ds_bpermute((lane ^ 16) << 2, __builtin_bit_cast(int, mx))));
                mx = fmaxf(mx, __builtin_bit_cast(float, __builtin_amdgcn_ds_bpermute((lane ^ 32) << 2, __builtin_bit_cast(int, mx))));
                if (fq == 0) xm[(ai * HALF + wr * 64 + m * 16 + fr) * 4 + wc] = mx; }
        asm volatile("s_waitcnt lgkmcnt(0)" ::: "memory"); __builtin_amdgcn_s_barrier(); asm volatile("" ::: "memory");
#pragma unroll
        for (int ai = 0; ai < 2; ++ai)
#pragma unroll
            for (int m = 0; m < 4; ++m) { const int r = ai * HALF + wr * 64 + m * 16 + fr; const f32x4 q = *(const PG8_LAS f32x4*)(xm + r * 4);
                const float M = fmaxf(fmaxf(q[0], q[1]), fmaxf(q[2], q[3])); float s = 0.f;
#pragma unroll
                for (int bj = 0; bj < 2; ++bj)
#pragma unroll
                    for (int n = 0; n < 2; ++n) { f32x4 v = acc[ai][bj][m][n];
#pragma unroll
                        for (int j = 0; j < 4; ++j) v[j] = __builtin_amdgcn_exp2f(v[j] - M);
                        s += (v[0] + v[1]) + (v[2] + v[3]); acc[ai][bj][m][n] = v; }
                s += __builtin_bit_cast(float, __builtin_amdgcn_ds_bpermute((lane ^ 16) << 2, __builtin_bit_cast(int, s)));
                s += __builtin_bit_cast(float, __builtin_amdgcn_ds_bpermute((lane ^ 32) << 2, __builtin_bit_cast(int, s)));
                if (fq == 0) xs[r * 4 + wc] = s; }
        asm volatile("s_waitcnt lgkmcnt(0)" ::: "memory"); __builtin_amdgcn_s_barrier(); asm volatile("" ::: "memory");
        const int col0 = u.pn * BM + wc * 32 + 8 * fq;
#pragma unroll
        for (int ai = 0; ai < 2; ++ai)
#pragma unroll
            for (int m = 0; m < 4; ++m) { const int r = ai * HALF + wr * 64 + m * 16 + fr; const f32x4 q = *(const PG8_LAS f32x4*)(xs + r * 4);
                const float inv = 1.0f / ((q[0] + q[1]) + (q[2] + q[3])); const size_t row = (size_t)u.pm * BM + r;
#pragma unroll
                for (int bj = 0; bj < 2; ++bj) { const f32x4 v0 = acc[ai][bj][m][0] * inv, v1 = acc[ai][bj][m][1] * inv;
                    u32x4 w; w.x = cvt_pk_bf16(v0[0], v0[1]); w.y = cvt_pk_bf16(v0[2], v0[3]); w.z = cvt_pk_bf16(v1[0], v1[1]); w.w = cvt_pk_bf16(v1[2], v1[3]);
                    *(u32x4*)(P + row * 1024 + col0 + bj * HALF) = w; } }
        asm volatile("s_waitcnt lgkmcnt(0)" ::: "memory");
    }
};

struct EpiF32 {
    static constexpr bool PERM = false, AFTER_DRAIN = false;
    float* out; long ldc;
    __device__ __forceinline__ void operator()(const f32x4 (&acc)[2][2][4][2], const Unit& u, int wr, int wc, int fr, int fq) const {
#pragma unroll
        for (int ai = 0; ai < 2; ++ai)
#pragma unroll
            for (int m = 0; m < 4; ++m) { const size_t off = (size_t)(u.pm * BM + ai * HALF + wr * 64 + m * 16 + fr) * ldc + u.pn * BM + wc * 32 + 4 * fq;
#pragma unroll
                for (int bj = 0; bj < 2; ++bj)
#pragma unroll
                    for (int n = 0; n < 2; ++n) *(f32x4*)(out + off + bj * HALF + n * 16) = acc[ai][bj][m][n]; }
    }
};

template <class Epi, class Sched, bool ALIGN_EPI = false, bool SP2 = false>
__device__ __forceinline__ void gemm_phase(PG8_LAS unsigned char* lds, const Gemm g, const Sched& S, const Epi& E, int tid_in) {
    int tid_l = tid_in; asm volatile("" : "+v"(tid_l));
    const int tid = tid_l, wid = __builtin_amdgcn_readfirstlane(tid >> 6), lane = tid & 63, wr = wid >> 2, wc = wid & 3, fr = lane & 15, fq = lane >> 4;
    const int K = g.K, nt = K / BK;
    unsigned voffA[2], voffB[2];
#pragma unroll
    for (int i = 0; i < 2; ++i) { int R, C; stage_rc(tid * 16 + i * 8192, R, C); const int Rb = Epi::PERM ? ((R & ~31) + perm32(R & 31)) : R;
        voffA[i] = (unsigned)(R * g.lda + C) * 2u; voffB[i] = (unsigned)(Rb * g.ldb + C) * 2u; }
    const size_t kstep = (size_t)(BK * 2);
    const size_t hstepA = (size_t)HALF * g.lda * 2, hstepB = (size_t)HALF * g.ldb * 2;

    const unsigned ldsw = (unsigned)wid * 1024u;
    const int aoff = lds_byte(wr * 64 + fr, fq * 8), boff = lds_byte(wc * 32 + fr, fq * 8);
#define PG8_SA(b, h) (((b) * 2 + (h)) * HTB)
#define PG8_SB(b, h) ((4 + (b) * 2 + (h)) * HTB)
#define PG8_STAGE(bufoff, gbase, voff) do { _Pragma("unroll") for (int _i = 0; _i < 2; ++_i) \
        __builtin_amdgcn_global_load_lds((const unsigned*)((const char*)(gbase) + (voff)[_i]), (PG8_LAS unsigned*)(lds + (bufoff) + ldsw + _i * 8192), 16, 0, 0); } while (0)
#define PG8_LDA(dst, b, h) do { _Pragma("unroll") for (int m = 0; m < 4; ++m) _Pragma("unroll") for (int k = 0; k < 2; ++k) dst[m][k] = *(const PG8_LAS bf16x8*)(lds + PG8_SA(b, h) + aoff + m * 2048 + k * 1024); } while (0)
#define PG8_LDB(dst, b, h) do { _Pragma("unroll") for (int n = 0; n < 2; ++n) _Pragma("unroll") for (int k = 0; k < 2; ++k) dst[n][k] = *(const PG8_LAS bf16x8*)(lds + PG8_SB(b, h) + boff + n * 2048 + k * 1024); } while (0)
#define PG8_MMA(ai, bj, At, Bt) do { __builtin_amdgcn_s_setprio(1); _Pragma("unroll") for (int m = 0; m < 4; ++m) _Pragma("unroll") for (int n = 0; n < 2; ++n) _Pragma("unroll") for (int k = 0; k < 2; ++k) \
        acc[ai][bj][m][n] = __builtin_amdgcn_mfma_f32_16x16x32_bf16(Bt[n][k], At[m][k], acc[ai][bj][m][n], 0, 0, 0); __builtin_amdgcn_s_setprio(0); } while (0)
#define PG8_WAIT_V(n) asm volatile("s_waitcnt vmcnt(" #n ")" ::: "memory")
#define PG8_WAIT_L(n) asm volatile("s_waitcnt lgkmcnt(" #n ")" ::: "memory")
#define PG8_BAR __builtin_amdgcn_s_barrier()
#define PG8_SCHED __builtin_amdgcn_sched_barrier(0)
    Unit cur, nxt; int ui = 0;
    if (!S.next(0, cur)) return;
    f32x4 acc[2][2][4][2];
#pragma unroll
    for (int a = 0; a < 2; ++a)
#pragma unroll
        for (int b = 0; b < 2; ++b)
#pragma unroll
            for (int m = 0; m < 4; ++m)
#pragma unroll
                for (int n = 0; n < 2; ++n) acc[a][b][m][n] = (f32x4){0.f, 0.f, 0.f, 0.f};
    bf16x8 At[4][2], B0[2][2], B1[2][2];
    const char* cA = g.uA(cur); const char* cB = g.uB(cur);
    S.a_ready(cur);
    if constexpr (SP2) {
        PG8_STAGE(PG8_SB(0, 0), cB, voffB); PG8_STAGE(PG8_SB(0, 1), cB + hstepB, voffB); PG8_STAGE(PG8_SA(0, 0), cA, voffA); PG8_STAGE(PG8_SA(0, 1), cA + hstepA, voffA);
        if (wr == 1) PG8_BAR;
        PG8_WAIT_V(2); PG8_BAR;
        PG8_STAGE(PG8_SB(1, 0), cB + kstep, voffB); PG8_STAGE(PG8_SA(1, 0), cA + kstep, voffA); PG8_STAGE(PG8_SB(1, 1), cB + hstepB + kstep, voffB);
        PG8_WAIT_V(6); PG8_BAR;
    } else {
        PG8_STAGE(PG8_SB(0, 0), cB, voffB); PG8_STAGE(PG8_SA(0, 0), cA, voffA); PG8_STAGE(PG8_SB(0, 1), cB + hstepB, voffB); PG8_STAGE(PG8_SA(0, 1), cA + hstepA, voffA);
        if (wr == 1) PG8_BAR;
        PG8_WAIT_V(4); PG8_BAR;
        PG8_STAGE(PG8_SB(1, 0), cB + kstep, voffB); PG8_STAGE(PG8_SA(1, 0), cA + kstep, voffA); PG8_STAGE(PG8_SB(1, 1), cB + hstepB + kstep, voffB);
        PG8_WAIT_V(6); PG8_BAR;
    }
    for (;;) {
        const bool has_next = S.next(ui + 1, nxt);
        const char* nA = has_next ? g.uA(nxt) : cA; const char* nB = has_next ? g.uB(nxt) : cB;
        for (int t = 0; t < nt; t += 2) {
            const bool last = (t == nt - 2);
            const char* a1 = cA + (size_t)(t + 1) * kstep;
            const char* a2 = last ? nA : cA + (size_t)(t + 2) * kstep; const char* b2 = last ? nB : cB + (size_t)(t + 2) * kstep;
            const char* a3 = a2 + kstep; const char* b3 = b2 + kstep;
            if (last && has_next) S.a_ready(nxt);
            if constexpr (SP2) {
            PG8_LDB(B0, 0, 0); PG8_LDB(B1, 0, 1); PG8_SCHED; PG8_LDA(At, 0, 0); PG8_STAGE(PG8_SA(1, 1), a1 + hstepA, voffA);
            PG8_WAIT_V(8); PG8_WAIT_L(0); PG8_BAR; PG8_MMA(0, 0, At, B0); PG8_MMA(0, 1, At, B1); PG8_BAR; PG8_SCHED;
            PG8_LDA(At, 0, 1); PG8_STAGE(PG8_SB(0, 0), b2, voffB); PG8_STAGE(PG8_SB(0, 1), b2 + hstepB, voffB); PG8_STAGE(PG8_SA(0, 0), a2, voffA);
            PG8_WAIT_V(8); PG8_WAIT_L(0); PG8_BAR; PG8_MMA(1, 0, At, B0); PG8_MMA(1, 1, At, B1); PG8_BAR; PG8_SCHED;
            PG8_LDB(B0, 1, 0); PG8_LDB(B1, 1, 1); PG8_SCHED; PG8_LDA(At, 1, 0); PG8_STAGE(PG8_SA(0, 1), a2 + hstepA, voffA);
            PG8_WAIT_V(8); PG8_WAIT_L(0); PG8_BAR; PG8_MMA(0, 0, At, B0); PG8_MMA(0, 1, At, B1); PG8_BAR; PG8_SCHED;
            PG8_LDA(At, 1, 1); PG8_STAGE(PG8_SB(1, 0), b3, voffB); PG8_STAGE(PG8_SB(1, 1), b3 + hstepB, voffB); PG8_STAGE(PG8_SA(1, 0), a3, voffA);
            PG8_WAIT_V(8); PG8_WAIT_L(0); PG8_BAR; PG8_MMA(1, 0, At, B0); PG8_MMA(1, 1, At, B1); PG8_BAR; PG8_SCHED;
            } else {
            PG8_LDB(B0, 0, 0); PG8_SCHED; PG8_LDA(At, 0, 0); PG8_STAGE(PG8_SA(1, 1), a1 + hstepA, voffA);
            PG8_WAIT_L(8); PG8_BAR; PG8_WAIT_L(0); PG8_MMA(0, 0, At, B0); PG8_BAR; PG8_SCHED;
            PG8_LDB(B1, 0, 1); PG8_STAGE(PG8_SB(0, 0), b2, voffB);
            PG8_BAR; PG8_WAIT_L(0); PG8_MMA(0, 1, At, B1); PG8_BAR;
            PG8_LDA(At, 0, 1); PG8_STAGE(PG8_SA(0, 0), a2, voffA);
            PG8_BAR; PG8_WAIT_L(0); PG8_MMA(1, 0, At, B0); PG8_BAR; PG8_SCHED;
            PG8_STAGE(PG8_SB(0, 1), b2 + hstepB, voffB);
            PG8_WAIT_V(6); PG8_BAR; PG8_MMA(1, 1, At, B1); PG8_BAR;
            PG8_LDB(B0, 1, 0); PG8_SCHED; PG8_LDA(At, 1, 0); PG8_STAGE(PG8_SA(0, 1), a2 + hstepA, voffA);
            PG8_WAIT_L(8); PG8_BAR; PG8_WAIT_L(0); PG8_MMA(0, 0, At, B0); PG8_BAR; PG8_SCHED;
            PG8_LDB(B1, 1, 1); PG8_STAGE(PG8_SB(1, 0), b3, voffB);
            PG8_BAR; PG8_WAIT_L(0); PG8_MMA(0, 1, At, B1); PG8_BAR;
            PG8_LDA(At, 1, 1); PG8_STAGE(PG8_SA(1, 0), a3, voffA);
            PG8_BAR; PG8_WAIT_L(0); PG8_MMA(1, 0, At, B0); PG8_BAR; PG8_SCHED;
            PG8_STAGE(PG8_SB(1, 1), b3 + hstepB, voffB);
            PG8_WAIT_V(6); PG8_BAR; PG8_MMA(1, 1, At, B1); PG8_BAR;
            }
        }
        if constexpr (ALIGN_EPI) { if (wr == 0) PG8_BAR; }
        if constexpr (!Epi::AFTER_DRAIN) { E(acc, cur, wr, wc, fr, fq); S.done(cur); }
        if (!has_next) break;
#pragma unroll
        for (int a = 0; a < 2; ++a)
#pragma unroll
            for (int b = 0; b < 2; ++b)
#pragma unroll
                for (int m = 0; m < 4; ++m)
#pragma unroll
                    for (int n = 0; n < 2; ++n) acc[a][b][m][n] = (f32x4){0.f, 0.f, 0.f, 0.f};
        cur = nxt; cA = nA; cB = nB; ++ui;
        if constexpr (ALIGN_EPI) { if (wr == 1) PG8_BAR; }
    }
    PG8_WAIT_V(0);
    if constexpr (!ALIGN_EPI) { if (wr == 0) PG8_BAR; }
    PG8_BAR;
    if constexpr (Epi::AFTER_DRAIN) { E.fused(acc, cur, wr, wc, fr, fq, lds, wid, lane); S.done(cur); }
#undef PG8_SA
#undef PG8_SB
#undef PG8_STAGE
#undef PG8_LDA
#undef PG8_LDB
#undef PG8_MMA
#undef PG8_WAIT_V
#undef PG8_WAIT_L
#undef PG8_BAR
#undef PG8_SCHED
}
}

#define LAS __attribute__((address_space(3)))
typedef unsigned short bf16;
typedef float f32x4 __attribute__((ext_vector_type(4)));
typedef float f32x16 __attribute__((ext_vector_type(16)));
typedef short bf16x8 __attribute__((ext_vector_type(8)));
typedef short s16x4 __attribute__((ext_vector_type(4)));
typedef unsigned u32x4 __attribute__((ext_vector_type(4)));
typedef unsigned u32x2 __attribute__((ext_vector_type(2)));

constexpr int NB = 16, SEQ = 4096, DM = 1024, DEPTH = 4, MEMLEN = 256;
constexpr int MTOK = NB * SEQ;
constexpr int MMEM = NB * MEMLEN;
constexpr int MLA_COLS = 352, RW = 512;
constexpr int IN0 = 2048, IN1 = 2080;
constexpr int DFF = 4096;
constexpr float EPS = 1e-6f, GN_EPS = 64e-5f;
constexpr float LOG2E = 1.4426950408889634f;
constexpr float MLA_QSCALE = 0.14724444602590306f;
constexpr float CA_QSCALE = 0.09016844005556021f;
constexpr int NTHREADS = 512, NWAVES = 8;
constexpr int LDS_BYTES = 147456;

constexpr size_t MiB = 1u << 20;
constexpr size_t WS_CTL = 0, CTL_BYTES = 1 * MiB;
constexpr size_t CTL_BAR = 4096, CTL_SS = 65536;
static_assert(CTL_SS + 3 * (size_t)MTOK * 4 <= CTL_BYTES, "ctl");
constexpr size_t WS_W = 1 * MiB;
constexpr size_t W_IN = WS_W;
constexpr size_t W_UQ = W_IN + (size_t)2304 * 1024 * 2;
constexpr size_t W_KN = W_UQ + (size_t)768 * 256 * 2;
constexpr size_t W_VT = W_KN + (size_t)512 * 128 * 2;
constexpr size_t W_LR = W_VT + (size_t)512 * 128 * 2;
constexpr size_t W_OUT = W_LR + (size_t)2048 * 256 * 2;
constexpr size_t W_CQ = W_OUT + (size_t)1024 * 1024 * 2;
constexpr size_t W_CKV = W_CQ + (size_t)1024 * 1024 * 2;
constexpr size_t W_CO = W_CKV + (size_t)2048 * 1024 * 2;
constexpr size_t W_UP = W_CO + (size_t)1024 * 1024 * 2;
constexpr size_t W_DN = W_UP + (size_t)4096 * 1024 * 2;
constexpr size_t W_END = W_DN + (size_t)4096 * 1024 * 2;
static_assert(W_END <= 35 * MiB, "weights");
constexpr size_t WS_MEMN = 35 * MiB;
constexpr size_t WS_MEMKV = 43 * MiB;
constexpr size_t WS_KROPE = 59 * MiB;
constexpr size_t WS_VFIRST = 64 * MiB;
constexpr size_t WS_XN = 128 * MiB;
constexpr size_t WS_Q = WS_XN;
constexpr size_t WS_PROJ = 256 * MiB;
constexpr size_t WS_S = 512 * MiB;
constexpr size_t WS_CQN = WS_S;
constexpr size_t WS_CKVN = WS_S + 32 * MiB;
constexpr size_t WS_ALR = WS_S + 48 * MiB;
constexpr size_t WS_PROJ2 = WS_S + 80 * MiB;
constexpr size_t WS_MIX = WS_S;
constexpr size_t WS_KN = 640 * MiB;
constexpr size_t WS_VT = 704 * MiB;
constexpr size_t WS_LOW = 768 * MiB;
constexpr size_t WS_NEED = 1024 * MiB;
constexpr size_t WS_WKT = 384 * MiB;
constexpr size_t WS_VWT = 416 * MiB;
constexpr size_t WS_P = 640 * MiB;
constexpr size_t WS_OCA = 768 * MiB;
constexpr size_t WS_HID = 256 * MiB;
constexpr size_t WS_HF32 = 768 * MiB;
constexpr size_t WS_SSP = 128 * MiB;

struct Args { const void* in[35]; float* out; unsigned char* ws; };
typedef const Args __attribute__((address_space(4)))* ArgsP;

__device__ __forceinline__ unsigned f2bf(float f) { unsigned u = __builtin_bit_cast(unsigned, f); return (u + 0x7fffu + ((u >> 16) & 1u)) >> 16; }
__device__ __forceinline__ unsigned pk2(float lo, float hi) { return f2bf(lo) | (f2bf(hi) << 16); }
__device__ __forceinline__ float bf2f(unsigned short b) { return __builtin_bit_cast(float, (unsigned)b << 16); }
__device__ __forceinline__ float bflo(unsigned w) { return __builtin_bit_cast(float, w << 16); }
__device__ __forceinline__ float bfhi(unsigned w) { return __builtin_bit_cast(float, w & 0xffff0000u); }
__device__ __forceinline__ float dppx1(float x) { return __builtin_bit_cast(float, __builtin_amdgcn_update_dpp(0, __builtin_bit_cast(int, x), 0xB1, 0xF, 0xF, true)); }
__device__ __forceinline__ float dppx2(float x) { return __builtin_bit_cast(float, __builtin_amdgcn_update_dpp(0, __builtin_bit_cast(int, x), 0x4E, 0xF, 0xF, true)); }
__device__ __forceinline__ float bperm(float x, int srclane) { return __builtin_bit_cast(float, __builtin_amdgcn_ds_bpermute(srclane << 2, __builtin_bit_cast(int, x))); }
__device__ __forceinline__ float dpp_hm_(float x) { return __builtin_bit_cast(float, __builtin_amdgcn_update_dpp(0, __builtin_bit_cast(int, x), 0x141, 0xF, 0xF, true)); }
__device__ __forceinline__ float dpp_rm_(float x) { return __builtin_bit_cast(float, __builtin_amdgcn_update_dpp(0, __builtin_bit_cast(int, x), 0x140, 0xF, 0xF, true)); }
__device__ __forceinline__ float wave_sum(float v, int lane) {
    v += dppx1(v); v += dppx2(v); v += dpp_hm_(v); v += dpp_rm_(v);
    v += bperm(v, lane ^ 16); v += bperm(v, lane ^ 32);
    return v;
}
__device__ __forceinline__ float wave_max(float v, int lane) {
    v = fmaxf(v, dppx1(v)); v = fmaxf(v, dppx2(v));
#pragma unroll
    for (int o = 4; o < 64; o <<= 1) v = fmaxf(v, bperm(v, lane ^ o));
    return v;
}
#define LDS_WAIT() asm volatile("s_waitcnt lgkmcnt(0)" ::: "memory")

struct Ctx { int tid, lane, wave, gw, ngw, bid, nblk; LAS unsigned char* lds; };


#define XB_TMO      128
#define XB_XCNT(j)  (256  + 64 * (j))
#define XB_XSUB(j)  (1280 + 64 * (j))
#define XB_XGEN(j)  (2304 + 64 * (j))
#define XB_TOP      3328
#define XB_TOPGEN   3392
#define XCD_BAR_WORDS 3456
#define XB_SPIN_CAP (1u << 23)
__device__ __forceinline__ unsigned xb_ld(unsigned* p)              { return __hip_atomic_load(p, __ATOMIC_RELAXED, __HIP_MEMORY_SCOPE_AGENT); }
__device__ __forceinline__ unsigned xb_add(unsigned* p, unsigned v) { return __hip_atomic_fetch_add(p, v, __ATOMIC_RELAXED, __HIP_MEMORY_SCOPE_AGENT); }
__device__ __forceinline__ unsigned xb_xcc_id() { return (unsigned)__builtin_amdgcn_s_getreg((3 << 11) | 20) & 0xFu; }
#define XB_SPIN(cond, bar) do { unsigned _sp = 0; while (cond) { __builtin_amdgcn_s_sleep(1); \
    if ((++_sp & 255u) == 0u) { if (xb_ld(&(bar)[XB_TMO])) break; if (_sp > XB_SPIN_CAP) { atomicAdd(&(bar)[XB_TMO], 1u); break; } } } } while (0)
__device__ __forceinline__ void xcd_barrier_post(unsigned* bar, int tid) { if (tid == 0) (void)xb_add(&bar[XB_XCNT(xb_xcc_id())], 1u); }
__device__ __forceinline__ void xcd_barrier_complete(unsigned* bar, unsigned x, unsigned G, unsigned& nloc, unsigned& nx) {
    unsigned sum, cnt, mine, sp = 0u;
    for (;;) {
        sum = 0u; cnt = 0u; mine = 0u;
#pragma unroll
        for (unsigned j = 0; j < 16; ++j) { const unsigned c = xb_ld(&bar[XB_XCNT(j)]); sum += c; cnt += (c > 0u) ? 1u : 0u; mine = (j == x) ? c : mine; }
        if (sum == G) break;
        __builtin_amdgcn_s_sleep(1);
        if ((++sp & 255u) == 0u) { if (xb_ld(&bar[XB_TMO])) break; if (sp > XB_SPIN_CAP) { atomicAdd(&bar[XB_TMO], 1u); break; } }
    }
    nloc = mine > 0u ? mine : 1u; nx = cnt > 0u ? cnt : 1u;
}
__device__ __forceinline__ void xcd_barrier(unsigned* bar, volatile LAS unsigned* st, int tid, unsigned G) {
    asm volatile("s_waitcnt vmcnt(0)" ::: "memory");
    __syncthreads();
    if (tid == 0) {
        __builtin_amdgcn_s_waitcnt(0);
        const unsigned x = xb_xcc_id();
        unsigned nloc = st[0], nx = st[1];
        if (nloc == 0u) { xcd_barrier_complete(bar, x, G, nloc, nx); st[0] = nloc; st[1] = nx; }
        const unsigned old = xb_add(&bar[XB_XSUB(x)], 1u);
        const unsigned gen = old / nloc;
        if (old + 1u == (gen + 1u) * nloc) {
            __builtin_amdgcn_fence(__ATOMIC_RELEASE, "agent");
            asm volatile("s_waitcnt vmcnt(0)" ::: "memory");
            const unsigned og = xb_add(&bar[XB_TOP], 1u);
            const unsigned tg = og / nx;
            if (og + 1u == (tg + 1u) * nx) xb_add(&bar[XB_TOPGEN], 1u);
            else XB_SPIN(xb_ld(&bar[XB_TOPGEN]) == tg, bar);
            __builtin_amdgcn_fence(__ATOMIC_ACQUIRE, "agent");
            xb_add(&bar[XB_XGEN(x)], 1u);
            asm volatile("s_waitcnt vmcnt(0)" ::: "memory");
        } else {
            XB_SPIN(xb_ld(&bar[XB_XGEN(x)]) == gen, bar);
            __builtin_amdgcn_fence(__ATOMIC_ACQUIRE, "agent");
            asm volatile("s_waitcnt vmcnt(0)" ::: "memory");
        }
    }
    __syncthreads();
}

__device__ __forceinline__ void transpose_item(const float* W, int K, int ldw, int nblk, bf16* WT, LAS float* scr, int item, int lane, const float* gain = nullptr) {
    const int kb = item / nblk, nb = item % nblk, k0 = 64 * kb, n0 = 32 * nb;
#pragma unroll
    for (int j = 0; j < 8; ++j) { const int kk = (lane >> 3) + 8 * j, nn = (lane & 7) * 4; const float gsc = gain ? gain[k0 + kk] : 1.0f;
        const f32x4 v = *(const f32x4*)(W + (size_t)(k0 + kk) * ldw + n0 + nn); LAS float* d = scr + kk * 33 + nn; d[0] = v.x * gsc; d[1] = v.y * gsc; d[2] = v.z * gsc; d[3] = v.w * gsc; }
    LDS_WAIT(); asm volatile("" ::: "memory");
    const int c = lane & 7;
#pragma unroll
    for (int j = 0; j < 4; ++j) { const int n = (lane >> 3) + 8 * j; const LAS float* s = scr + (8 * c) * 33 + n;
        u32x4 o; o.x = pk2(s[0 * 33], s[1 * 33]); o.y = pk2(s[2 * 33], s[3 * 33]); o.z = pk2(s[4 * 33], s[5 * 33]); o.w = pk2(s[6 * 33], s[7 * 33]);
        *(u32x4*)(WT + (size_t)(n0 + n) * K + k0 + 8 * c) = o; }
    LDS_WAIT(); asm volatile("" ::: "memory");
}
__device__ __forceinline__ void rms_row_to_bf16(const float* xrow, const float* gain, bf16* orow, int lane) {
    const f32x4* xr = (const f32x4*)xrow + lane; const f32x4* gr = (const f32x4*)gain + lane;
    f32x4 v[4]; float s = 0.f;
#pragma unroll
    for (int j = 0; j < 4; ++j) { v[j] = xr[64 * j]; s += (v[j].x * v[j].x + v[j].y * v[j].y) + (v[j].z * v[j].z + v[j].w * v[j].w); }
    const float rs = 1.0f / sqrtf(wave_sum(s, lane) * (1.0f / 1024.0f) + EPS);
    unsigned long long* o8 = (unsigned long long*)orow + lane;
#pragma unroll
    for (int j = 0; j < 4; ++j) { const f32x4 g = gr[64 * j]; o8[64 * j] = (unsigned long long)pk2(v[j].x * rs * g.x, v[j].y * rs * g.y) | ((unsigned long long)pk2(v[j].z * rs * g.z, v[j].w * rs * g.w) << 32); }
}

template <int PART  > __device__ __forceinline__ void convert_weights(const Ctx& c, ArgsP ap, unsigned char* ws, int l) {
    LAS float* scr = (LAS float*)(c.lds + c.wave * 16384);
    const float* w_in = l == 0 ? (const float*)ap->in[4] : (const float*)ap->in[5] + (size_t)(l - 1) * 1024 * IN1;
    const int n_in = l == 0 ? IN0 : IN1;
    const float* w_out = (const float*)ap->in[25] + (size_t)l * 1024 * 1024;
    const float* cwq = (const float*)ap->in[28] + (size_t)l * 1024 * 1024;
    const float* cwkv = (const float*)ap->in[29] + (size_t)l * 1024 * 2048;
    const float* cwo = (const float*)ap->in[30] + (size_t)l * 1024 * 1024;
    const float* wup = (const float*)ap->in[32] + (size_t)l * 1024 * 4096;
    const float* wdn = (const float*)ap->in[33] + (size_t)l * 4096 * 1024;
    const int I_IN = 16 * (n_in / 32), I_SQ = 16 * 32, I_KV = 16 * 64, I_UP = 16 * 128, I_DN = 64 * 32;
    if (PART == 0) {
        for (int it = c.gw; it < I_IN + I_SQ; it += c.ngw) {
            int r = it;
            if (r < I_IN) { transpose_item(w_in, 1024, n_in, n_in / 32, (bf16*)(ws + W_IN), scr, r, c.lane, (const float*)ap->in[3] + l * 1024); continue; } r -= I_IN;
            transpose_item(w_out, 1024, 1024, 32, (bf16*)(ws + W_OUT), scr, r, c.lane);
        }
    } else {
        for (int it = c.gw; it < 2 * I_SQ + I_KV + I_UP + I_DN; it += c.ngw) {
            int r = it;
            if (r < I_SQ) { const f32x4* s4 = (const f32x4*)(cwq + (size_t)r * 2048) + c.lane; u32x2* d2 = (u32x2*)((bf16*)(ws + W_CQ) + (size_t)r * 2048) + c.lane;
#pragma unroll
                for (int j = 0; j < 8; ++j) { const float gsc = ((const float*)ap->in[26])[l * 1024 + 2 * r + (j >> 2)]; const f32x4 v = s4[64 * j] * gsc; u32x2 o; o.x = pk2(v.x, v.y); o.y = pk2(v.z, v.w); d2[64 * j] = o; } continue; } r -= I_SQ;
            if (r < I_SQ) { transpose_item(cwo, 1024, 1024, 32, (bf16*)(ws + W_CO), scr, r, c.lane); continue; } r -= I_SQ;
            if (r < I_KV) { transpose_item(cwkv, 1024, 2048, 64, (bf16*)(ws + W_CKV), scr, r, c.lane); continue; } r -= I_KV;
            if (r < I_UP) { transpose_item(wup, 1024, 4096, 128, (bf16*)(ws + W_UP), scr, r, c.lane, (const float*)ap->in[31] + l * 1024); continue; } r -= I_UP;
            transpose_item(wdn, 4096, 1024, 32, (bf16*)(ws + W_DN), scr, r, c.lane);
        }
        return;
    }
    const int gb = c.gw * 64, ngt = c.ngw * 64;
    const float* wuq = (const float*)ap->in[9] + (size_t)l * 192 * 768;
    const float* wukv = (const float*)ap->in[11] + (size_t)l * 128 * 1024;
    const float* w2 = (const float*)ap->in[14] + (size_t)l * 32 * 512;
    const float* a2 = (const float*)ap->in[16] + (size_t)l * 32 * 512;
    const float* g2 = (const float*)ap->in[17] + (size_t)l * 96 * 512;
    const float* v2 = l > 0 ? (const float*)ap->in[19] + (size_t)(l - 1) * 32 * 512 : nullptr;
    bf16* WUQ = (bf16*)(ws + W_UQ); bf16* WKN = (bf16*)(ws + W_KN); bf16* WVT = (bf16*)(ws + W_VT); bf16* WLR = (bf16*)(ws + W_LR); bf16* WIN = (bf16*)(ws + W_IN);
    for (int eb = gb; eb < 768 * 256; eb += ngt) { const int e = eb + c.lane; const int n = e >> 8, k = e & 255; WUQ[e] = (bf16)(k < 192 ? f2bf(wuq[k * 768 + n]) : 0u); }
    for (int eb = gb; eb < 512 * 128; eb += ngt) { const int e = eb + c.lane; const int n = e >> 7, k = e & 127, h = n >> 6, d = n & 63;
        WKN[e] = (bf16)f2bf(wukv[k * 1024 + h * 128 + d]); WVT[e] = (bf16)f2bf(wukv[k * 1024 + h * 128 + 64 + d]); }
    for (int eb = gb; eb < 2048 * 256; eb += ngt) { const int e = eb + c.lane; const int n = e >> 8, k = e & 255, kind = n >> 9, cc = n & 511; float v = 0.f;
        if (kind == 0) { if (k < 32) v = w2[k * 512 + cc]; }
        else if (kind == 1) { if (k >= 32 && k < 64) v = a2[(k - 32) * 512 + cc]; }
        else if (kind == 2) { if (k >= 64 && k < 160) v = g2[(k - 64) * 512 + cc]; }
        else { if (v2 && k >= 160 && k < 192) v = v2[(k - 160) * 512 + cc]; }
        WLR[e] = (bf16)f2bf(v); }
    for (int eb = gb; eb < (2304 - n_in) * 1024; eb += ngt) WIN[(size_t)n_in * 1024 + eb + c.lane] = 0;
}

__device__ __forceinline__ void prep_pass(const Ctx& c, ArgsP ap, unsigned char* ws, int l) {
    const bf16* __restrict__ proj = (const bf16*)(ws + WS_PROJ); const bf16* __restrict__ proj2 = (const bf16*)(ws + WS_PROJ2);
    bf16* __restrict__ cqn = (bf16*)(ws + WS_CQN); bf16* __restrict__ ckvn = (bf16*)(ws + WS_CKVN); bf16* __restrict__ alr = (bf16*)(ws + WS_ALR); bf16* __restrict__ krope = (bf16*)(ws + WS_KROPE);
    const int* pos = (const int*)ap->in[2];
    const float* qn = (const float*)ap->in[8] + l * 192; const float* kvn = (const float*)ap->in[10] + l * 128;
    const float* mu = l == 0 ? (const float*)ap->in[6] : (const float*)ap->in[7] + (size_t)(l - 1) * 1728;
    const int lane = c.lane;
#pragma unroll 4
    for (int row = c.gw; row < MTOK; row += c.ngw) {
        const bf16* __restrict__ P = proj + (size_t)row * 2048;
        { float v[4] = {0.f, 0.f, 0.f, 0.f}; float ss = 0.f;
          if (lane < 48) { const u32x2 w = *(const u32x2*)(P + 4 * lane); v[0] = bflo(w.x); v[1] = bfhi(w.x); v[2] = bflo(w.y); v[3] = bfhi(w.y); ss = (v[0] * v[0] + v[1] * v[1]) + (v[2] * v[2] + v[3] * v[3]); }
          const float rs = 1.0f / sqrtf(wave_sum(ss, lane) * (1.0f / 192.0f) + EPS);
          u32x2 o; o.x = 0u; o.y = 0u;
          if (lane < 48) { const f32x4 g = *(const f32x4*)(qn + 4 * lane); o.x = pk2(v[0] * rs * g.x, v[1] * rs * g.y); o.y = pk2(v[2] * rs * g.z, v[3] * rs * g.w); }
          *(u32x2*)(cqn + (size_t)row * 256 + 4 * lane) = o; }
        { float v[4] = {0.f, 0.f, 0.f, 0.f}; float ss = 0.f;
          if (lane < 32) { const u32x2 w = *(const u32x2*)(P + 192 + 4 * lane); v[0] = bflo(w.x); v[1] = bfhi(w.x); v[2] = bflo(w.y); v[3] = bfhi(w.y); ss = (v[0] * v[0] + v[1] * v[1]) + (v[2] * v[2] + v[3] * v[3]); }
          const float rs = 1.0f / sqrtf(wave_sum(ss, lane) * (1.0f / 128.0f) + EPS);
          if (lane < 32) { const f32x4 g = *(const f32x4*)(kvn + 4 * lane); u32x2 o; o.x = pk2(v[0] * rs * g.x, v[1] * rs * g.y); o.y = pk2(v[2] * rs * g.z, v[3] * rs * g.w);
              *(u32x2*)(ckvn + (size_t)row * 128 + 4 * lane) = o; } }
        if (lane < 16) { const float x1 = bf2f(P[320 + lane]), x2 = bf2f(P[336 + lane]); float cs, sn; pg8::rope_cs(pos[row], lane, cs, sn);
            krope[(size_t)row * 32 + lane] = (bf16)f2bf(x1 * cs - x2 * sn); krope[(size_t)row * 32 + 16 + lane] = (bf16)f2bf(x1 * sn + x2 * cs); }
        { u32x2 o; o.x = 0u; o.y = 0u;
          const bool has_prev = (row & (SEQ - 1)) != 0;
          if (lane < 40 || (lane < 48 && l > 0)) {
              const bf16* src = lane < 40 ? P + 1888 + 4 * lane : proj2 + (size_t)row * 32 + 4 * (lane - 40);
              const bf16* psrc = lane < 40 ? P - 2048 + 1888 + 4 * lane : proj2 + (size_t)row * 32 - 32 + 4 * (lane - 40);
              const u32x2 w = *(const u32x2*)src; float cur[4] = {bflo(w.x), bfhi(w.x), bflo(w.y), bfhi(w.y)}; float prv[4] = {0.f, 0.f, 0.f, 0.f};
              if (has_prev) { const u32x2 pw = *(const u32x2*)psrc; prv[0] = bflo(pw.x); prv[1] = bfhi(pw.x); prv[2] = bflo(pw.y); prv[3] = bfhi(pw.y); }
              const f32x4 m4 = *(const f32x4*)(mu + 1536 + 4 * lane); const float mm[4] = {m4.x, m4.y, m4.z, m4.w}; float z[4];
#pragma unroll
              for (int j = 0; j < 4; ++j) { z[j] = cur[j] + (prv[j] - cur[j]) * mm[j];
                  if (lane < 8) z[j] = 1.0f - 2.0f / (__expf(2.0f * z[j]) + 1.0f); else if (lane >= 16 && lane < 40) z[j] = pg8::sigmoidf_(z[j]); }
              o.x = pk2(z[0], z[1]); o.y = pk2(z[2], z[3]); }
          *(u32x2*)(alr + (size_t)row * 256 + 4 * lane) = o; }
    }
}


#define MFMA32(a, b, c) __builtin_amdgcn_mfma_f32_32x32x16_bf16((a), (b), (c), 0, 0, 0)
constexpr int AT_KROW = 208, AT_VROW = 144;
constexpr int AT_KBYTES = 64 * AT_KROW, AT_VBYTES = 64 * AT_VROW;
constexpr int AT_BUF = AT_KBYTES + AT_VBYTES;
constexpr int AT_WSF = 2 * AT_BUF;
constexpr int AT_CTRL = AT_WSF + 8 * 256;
__device__ __forceinline__ float max3f(float a, float b, float c) { float r; asm("v_max3_f32 %0, %1, %2, %3" : "=v"(r) : "v"(a), "v"(b), "v"(c)); return r; }
__device__ __forceinline__ int crow(int r, int hi) { return (r & 3) + 8 * (r >> 2) + 4 * hi; }
__device__ __forceinline__ unsigned cvtpk(float lo, float hi) { typedef float f2 __attribute__((ext_vector_type(2))); typedef __bf16 b2 __attribute__((ext_vector_type(2))); f2 v = {lo, hi}; b2 b = __builtin_convertvector(v, b2); return __builtin_bit_cast(unsigned, b); }

__device__ __forceinline__ void mla_attn_unit(const Ctx& c, unsigned char* ws, const float* out_norm, int b, int h, int qb) {
    const int tid = c.tid, lane = c.lane, wid = c.wave, r32 = lane & 31, hi = lane >> 5;
    const bf16* Q = (const bf16*)(ws + WS_Q); const bf16* KN = (const bf16*)(ws + WS_KN); const bf16* KR = (const bf16*)(ws + WS_KROPE); const bf16* VT = (const bf16*)(ws + WS_VT);
    bf16* MIX = (bf16*)(ws + WS_MIX);
    const long rowbase = (long)b * SEQ; const int q0 = qb * 256;
    LAS unsigned char* lds = c.lds;
    LAS float* wsf = (LAS float*)(lds + AT_WSF) + wid * 64;
    bf16x8 qr[6];
    { const bf16* qp = Q + (rowbase + q0 + wid * 32 + r32) * 768 + h * 96 + hi * 8;
#pragma unroll
      for (int s = 0; s < 6; ++s) qr[s] = *(const bf16x8*)(qp + 16 * s); }
    const int nt = 4 * qb + 4;
    const int my_nt = 4 * qb + (wid >> 1) + 1;
    const int krow = tid >> 3, kch = tid & 7;
    const bf16* kn_src = KN + (rowbase + krow) * 512 + h * 64 + kch * 8;
    const bf16* vt_src = VT + ((size_t)((b * 8 + h) * 64) << 12) + krow * 64 + kch * 8;
    const int rrow = (tid & 255) >> 2, rch = tid & 3;
    const bf16* kr_src = KR + (rowbase + rrow) * 32 + rch * 8;
    const int k_dst = krow * AT_KROW + kch * 16, v_dst = AT_KBYTES + krow * AT_VROW + kch * 16, r_dst = rrow * AT_KROW + 128 + rch * 16;
    u32x4 gk, gv, gr;
#define AT_LOAD(t) do { gk = *(const u32x4*)(kn_src + (size_t)(t) * 64 * 512); gv = *(const u32x4*)(vt_src + (size_t)(t) * 4096); if (tid < 256) gr = *(const u32x4*)(kr_src + (size_t)(t) * 64 * 32); } while (0)
#define AT_STORE(bufo) do { *(LAS u32x4*)(lds + (bufo) + k_dst) = gk; *(LAS u32x4*)(lds + (bufo) + v_dst) = gv; if (tid < 256) *(LAS u32x4*)(lds + (bufo) + r_dst) = gr; } while (0)
    float m_run = 0.f, l_run = 0.f;
    f32x16 negm;
#pragma unroll
    for (int i = 0; i < 16; ++i) negm[i] = 0.f;
    f32x16 o0 = {0}, o1 = {0};
#pragma unroll
    for (int i = 0; i < 16; ++i) { o0[i] = 0.f; o1[i] = 0.f; }
    AT_LOAD(0); AT_STORE(0);
    __syncthreads();
    for (int t = 0; t < nt; ++t) {
        const int bufo = (t & 1) * AT_BUF;
        if (t + 1 < nt) AT_LOAD(t + 1);
        if (t < my_nt) {
            const LAS unsigned char* kb = lds + bufo + r32 * AT_KROW + hi * 16;
            f32x16 p0, p1;
            { const bf16x8 a0 = *(const LAS bf16x8*)(kb); const bf16x8 a1 = *(const LAS bf16x8*)(kb + 32 * AT_KROW);
              p0 = MFMA32(a0, qr[0], negm); p1 = MFMA32(a1, qr[0], negm); }
#pragma unroll
            for (int s = 1; s < 6; ++s) {
                const bf16x8 a0 = *(const LAS bf16x8*)(kb + s * 32);
                const bf16x8 a1 = *(const LAS bf16x8*)(kb + 32 * AT_KROW + s * 32);
                p0 = MFMA32(a0, qr[s], p0); p1 = MFMA32(a1, qr[s], p1);
            }
            asm volatile("s_nop 15\n\ts_nop 7" : "+v"(p0), "+v"(p1));
            float mx;
            { float xa = max3f(p0[0], p0[1], p1[0]), xb = max3f(p0[2], p0[3], p1[1]); xa = max3f(xa, p1[2], p1[3]);
#pragma unroll
              for (int r = 4; r < 16; r += 4) { xa = max3f(xa, p0[r], p0[r + 1]); xb = max3f(xb, p0[r + 2], p0[r + 3]); xa = max3f(xa, p1[r], p1[r + 1]); xb = max3f(xb, p1[r + 2], p1[r + 3]); }
              mx = fmaxf(xa, xb); }
            mx = fmaxf(mx, bperm(mx, lane ^ 32));
            const bool first = (t == 0);
            if (first || __builtin_amdgcn_ballot_w64(mx > 0.f) != 0ull) {
                const float dl = first ? mx : fmaxf(mx, 0.f);
                const float alpha = __builtin_amdgcn_exp2f(-dl);
                m_run += dl; l_run *= alpha;
#pragma unroll
                for (int i = 0; i < 16; ++i) { p0[i] -= dl; p1[i] -= dl; negm[i] = -m_run; }
                if (hi == 0) wsf[r32] = alpha;
                LDS_WAIT();
#pragma unroll
                for (int i = 0; i < 16; ++i) { const float f = wsf[crow(i, hi)]; o0[i] *= f; o1[i] *= f; }
            }
            float ps = 0.f;
#pragma unroll
            for (int i = 0; i < 16; ++i) { p0[i] = __builtin_amdgcn_exp2f(p0[i]); p1[i] = __builtin_amdgcn_exp2f(p1[i]); ps += p0[i] + p1[i]; }
            l_run += ps;
            const LAS unsigned char* vb = lds + bufo + AT_KBYTES + r32 * AT_VROW + hi * 8;
#pragma unroll
            for (int half = 0; half < 2; ++half) {
#pragma unroll
                for (int s = 0; s < 2; ++s) {
                    u32x4 pw;
                    if (half == 0) { pw.x = cvtpk(p0[8 * s], p0[8 * s + 1]); pw.y = cvtpk(p0[8 * s + 2], p0[8 * s + 3]); pw.z = cvtpk(p0[8 * s + 4], p0[8 * s + 5]); pw.w = cvtpk(p0[8 * s + 6], p0[8 * s + 7]); }
                    else { pw.x = cvtpk(p1[8 * s], p1[8 * s + 1]); pw.y = cvtpk(p1[8 * s + 2], p1[8 * s + 3]); pw.z = cvtpk(p1[8 * s + 4], p1[8 * s + 5]); pw.w = cvtpk(p1[8 * s + 6], p1[8 * s + 7]); }
                    const bf16x8 pa = __builtin_bit_cast(bf16x8, pw);
                    const int ko = (half * 32 + s * 16) * 2;
                    const s16x4 lo0 = *(const LAS s16x4*)(vb + ko), hi0 = *(const LAS s16x4*)(vb + ko + 16);
                    const s16x4 lo1 = *(const LAS s16x4*)(vb + 32 * AT_VROW + ko), hi1 = *(const LAS s16x4*)(vb + 32 * AT_VROW + ko + 16);
                    const bf16x8 v0 = __builtin_shufflevector(lo0, hi0, 0, 1, 2, 3, 4, 5, 6, 7);
                    const bf16x8 v1 = __builtin_shufflevector(lo1, hi1, 0, 1, 2, 3, 4, 5, 6, 7);
                    o0 = MFMA32(pa, v0, o0); o1 = MFMA32(pa, v1, o1);
                }
            }
        }
        if (t + 1 < nt) AT_STORE(((t + 1) & 1) * AT_BUF);
        __syncthreads();
    }
#undef AT_LOAD
#undef AT_STORE
    l_run += bperm(l_run, lane ^ 32);
    if (hi == 0) wsf[r32] = l_run;
    LDS_WAIT();
    const float g0 = out_norm[h * 64 + r32], g1 = out_norm[h * 64 + 32 + r32];
#pragma unroll
    for (int i = 0; i < 16; ++i) {
        const float il = 1.0f / wsf[crow(i, hi)];
        const float a = o0[i] * il, bb = o1[i] * il;
        float ss = a * a + bb * bb;
        ss += dppx1(ss); ss += dppx2(ss); ss += bperm(ss, lane ^ 4); ss += bperm(ss, lane ^ 8); ss += bperm(ss, lane ^ 16);
        const float rs = 1.0f / sqrtf(ss * (1.0f / 64.0f) + EPS);
        bf16* op = MIX + (rowbase + q0 + wid * 32 + crow(i, hi)) * 1024 + h * 64 + r32;
        op[0] = (bf16)f2bf(a * rs * g0); op[32] = (bf16)f2bf(bb * rs * g1);
    }
    LDS_WAIT();
    __syncthreads();
}

typedef float f32x2 __attribute__((ext_vector_type(2)));
constexpr int SC_T = 32, SC_NCH = SEQ / SC_T;
constexpr int SC_ARR = SC_T * 64 * 4;
constexpr int SC_KK = 0, SC_W = SC_ARR, SC_B = 2 * SC_ARR, SC_K = 3 * SC_ARR, SC_WR = 4 * SC_ARR, SC_V = 5 * SC_ARR, SC_Y = 6 * SC_ARR, SC_SC = 7 * SC_ARR  , SC_BON = SC_SC + SC_T * 8  , SC_BUF = SC_BON + SC_T * 4 + 128;
static_assert(2 * SC_BUF <= 131072, "scan LDS");
__device__ __forceinline__ float dpp_hm(float x) { return __builtin_bit_cast(float, __builtin_amdgcn_update_dpp(0, __builtin_bit_cast(int, x), 0x141, 0xF, 0xF, true)); }
__device__ __forceinline__ float dpp_rm(float x) { return __builtin_bit_cast(float, __builtin_amdgcn_update_dpp(0, __builtin_bit_cast(int, x), 0x140, 0xF, 0xF, true)); }
__device__ __forceinline__ float red8(float v) { v += dppx1(v); v += dppx2(v); v += dpp_hm(v); return v; }
__device__ __forceinline__ float red16(float v) { v += dppx1(v); v += dppx2(v); v += dpp_hm(v); v += dpp_rm(v); return v; }
__device__ __forceinline__ f32x4 unpk4(u32x2 w) { f32x4 r; r.x = bflo(w.x); r.y = bfhi(w.x); r.z = bflo(w.y); r.w = bfhi(w.y); return r; }
__device__ __forceinline__ float hsum4(f32x4 v) { return (v.x + v.y) + (v.z + v.w); }

struct ScanP { const bf16* proj; const bf16* low; bf16* vfirst; bf16* mix; const float* mu; const float* k_k; const float* k_a; const float* r_k; const float* ln_w; const float* ln_b; int layer; };
struct ScanRaw { u32x2 r, k, v, rp, kp, vp, e, a, vg, vf; };
struct ScanC { f32x4 mu_r, mu_k, mu_v, kk_c, ka_c, rk_c, lnw, lnb; };

__device__ __forceinline__ ScanRaw scan_load_raw(const ScanP& p, int chunk, int t, int b, int colb) {
    ScanRaw x; const int s = chunk * SC_T + t; const size_t row = (size_t)b * SEQ + s;
    const bf16* pr = p.proj + row * 2048 + MLA_COLS + colb;
    x.r = *(const u32x2*)pr; x.k = *(const u32x2*)(pr + 512); x.v = *(const u32x2*)(pr + 1024);
    const u32x2 z = {0u, 0u};
    x.rp = z; x.kp = z; x.vp = z;
    if (s > 0) { x.rp = *(const u32x2*)(pr - 2048); x.kp = *(const u32x2*)(pr + 512 - 2048); x.vp = *(const u32x2*)(pr + 1024 - 2048); }
    const bf16* lw = p.low + row * 2048 + colb;
    x.e = *(const u32x2*)lw; x.a = *(const u32x2*)(lw + 512);
    x.vg = z; x.vf = z;
    if (p.layer > 0) { x.vg = *(const u32x2*)(lw + 1536); x.vf = *(const u32x2*)(p.vfirst + row * 512 + colb); }
    return x;
}
__device__ __forceinline__ void scan_stage_write(const ScanP& p, const ScanRaw& x, const ScanC& k, LAS unsigned char* lds, int bufo, int chunk, int t, int b, int colb, int cg) {
    const f32x4 rc = unpk4(x.r), kc = unpk4(x.k), vc = unpk4(x.v), rpv = unpk4(x.rp), kpv = unpk4(x.kp), vpv = unpk4(x.vp);
    const f32x4 r = rc + (rpv - rc) * k.mu_r, kx = kc + (kpv - kc) * k.mu_k; f32x4 v = vc + (vpv - vc) * k.mu_v;
    const f32x4 e = unpk4(x.e), a = unpk4(x.a);
    f32x4 w; w.x = __builtin_amdgcn_exp2f(e.x); w.y = __builtin_amdgcn_exp2f(e.y); w.z = __builtin_amdgcn_exp2f(e.z); w.w = __builtin_amdgcn_exp2f(e.w);
    const int s = chunk * SC_T + t; const size_t row = (size_t)b * SEQ + s;
    if (p.layer == 0) { u32x2 o; o.x = cvtpk(v.x, v.y); o.y = cvtpk(v.z, v.w); *(u32x2*)(p.vfirst + row * 512 + colb) = o; }
    else { const f32x4 vg = unpk4(x.vg), vf = unpk4(x.vf); v = v + (vf - v) * vg; }
    f32x4 kk = kx * k.kk_c; const float n2 = red16(hsum4(kk * kk)); kk = kk * __builtin_amdgcn_rsqf(fmaxf(n2, 1e-24f));
    const f32x4 kmod = kx * (1.0f + (a - 1.0f) * k.ka_c);
    const f32x4 bv = kk * a, wr = w * r;
    const float br = red16(hsum4(bv * r)), kr = red16(hsum4(kmod * r)), bonus = red16(hsum4(r * kmod * k.rk_c));
    LAS unsigned char* base = lds + bufo + t * 256 + cg * 16;
    *(LAS f32x4*)(base + SC_KK) = kk; *(LAS f32x4*)(base + SC_W) = w; *(LAS f32x4*)(base + SC_B) = bv; *(LAS f32x4*)(base + SC_K) = kmod; *(LAS f32x4*)(base + SC_WR) = wr; *(LAS f32x4*)(base + SC_V) = v;
    if (cg == 0) { f32x2 sc; sc.x = br; sc.y = kr; *(LAS f32x2*)(lds + bufo + SC_SC + t * 8) = sc; *(LAS float*)(lds + bufo + SC_BON + t * 4) = bonus; }
}
struct ScanPost { f32x4 y, v; float bonus; };
__device__ __forceinline__ ScanPost scan_post_read(LAS unsigned char* lds, int bufo, int t, int cg) {
    ScanPost q; const LAS unsigned char* base = lds + bufo + t * 256 + cg * 16;
    q.y = *(const LAS f32x4*)(base + SC_Y); q.v = *(const LAS f32x4*)(base + SC_V); q.bonus = *(const LAS float*)(lds + bufo + SC_BON + t * 4); return q;
}
__device__ __forceinline__ void scan_post_finish(const ScanP& p, const ScanPost& q, u32x2 graw, const ScanC& k, int chunk, int t, int b, int colb) {
    const int s = chunk * SC_T + t; const size_t row = (size_t)b * SEQ + s;
    const float mean = red16(hsum4(q.y)) * (1.0f / 64.0f); const f32x4 d = q.y - mean; const float var = red16(hsum4(d * d)) * (1.0f / 64.0f);
    const float rs = __builtin_amdgcn_rsqf(var + GN_EPS);
    const f32x4 g = unpk4(graw);
    const f32x4 yn = (d * rs * k.lnw + k.lnb + q.v * q.bonus) * g;
    u32x2 o; o.x = cvtpk(yn.x, yn.y); o.y = cvtpk(yn.z, yn.w);
    *(u32x2*)(p.mix + row * 1024 + 512 + colb) = o;
}

struct StepIn { f32x4 kk[4], w[4], b[4], k[4], wr[4]; float vv; f32x2 sc; };
__device__ __forceinline__ StepIn scan_ld_step(const LAS unsigned char* bb, int t, int kq, int row) {
    StepIn x; const LAS unsigned char* p = bb + t * 256 + kq * 64;
#pragma unroll
    for (int i = 0; i < 4; ++i) x.kk[i] = *(const LAS f32x4*)(p + SC_KK + 16 * i);
#pragma unroll
    for (int i = 0; i < 4; ++i) x.wr[i] = *(const LAS f32x4*)(p + SC_WR + 16 * i);
#pragma unroll
    for (int i = 0; i < 4; ++i) x.k[i] = *(const LAS f32x4*)(p + SC_K + 16 * i);
#pragma unroll
    for (int i = 0; i < 4; ++i) x.b[i] = *(const LAS f32x4*)(p + SC_B + 16 * i);
#pragma unroll
    for (int i = 0; i < 4; ++i) x.w[i] = *(const LAS f32x4*)(p + SC_W + 16 * i);
    x.vv = *(const LAS float*)(bb + SC_V + t * 256 + row * 4);
    x.sc = *(const LAS f32x2*)(bb + SC_SC + t * 8);
    return x;
}
#define PKFMA(a, b, c) __builtin_elementwise_fma((a), (b), (c))
#define LO2(v) ((f32x2){(v).x, (v).y})
#define HI2(v) ((f32x2){(v).z, (v).w})
__device__ __forceinline__ void scan_do_step(f32x2 (&S)[8], const StepIn& x, LAS unsigned char* bb, int t, int kq, int row) {
    f32x2 sa2 = S[0] * LO2(x.kk[0]), sb2 = S[1] * HI2(x.kk[0]);
    f32x2 ya2 = S[0] * LO2(x.wr[0]), yb2 = S[1] * HI2(x.wr[0]);
#pragma unroll
    for (int i = 1; i < 4; ++i) { sa2 = PKFMA(S[2 * i], LO2(x.kk[i]), sa2); sb2 = PKFMA(S[2 * i + 1], HI2(x.kk[i]), sb2); ya2 = PKFMA(S[2 * i], LO2(x.wr[i]), ya2); yb2 = PKFMA(S[2 * i + 1], HI2(x.wr[i]), yb2); }
    sa2 = sa2 + sb2; ya2 = ya2 + yb2;
    float sa = sa2.x + sa2.y, yv = ya2.x + ya2.y;
    sa += dppx1(sa); yv += dppx1(yv); sa += dppx2(sa); yv += dppx2(yv);
    sa = -sa;
    const float yo = yv + sa * x.sc.x + x.vv * x.sc.y;
    const f32x2 sav = {sa, sa}, vvv = {x.vv, x.vv};
#pragma unroll
    for (int i = 0; i < 4; ++i) {
        f32x2 t0 = vvv * LO2(x.k[i]), t1 = vvv * HI2(x.k[i]);
        t0 = PKFMA(sav, LO2(x.b[i]), t0); t1 = PKFMA(sav, HI2(x.b[i]), t1);
        S[2 * i] = PKFMA(S[2 * i], LO2(x.w[i]), t0); S[2 * i + 1] = PKFMA(S[2 * i + 1], HI2(x.w[i]), t1);
    }
    if (kq == 0) *(LAS float*)(bb + SC_Y + t * 256 + row * 4) = yo;
}

__device__ __forceinline__ void scan_unit(const Ctx& c, const ScanP& p, int b, int h) {
    LAS unsigned char* lds = c.lds; const int lane = c.lane, wid = c.wave;
    if (wid >= 4) {
        const int sw = wid - 4, tq = lane >> 4, cg = lane & 15, colb = h * 64 + 4 * cg;
        ScanC k; k.mu_r = *(const f32x4*)(p.mu + colb); k.mu_k = *(const f32x4*)(p.mu + 512 + colb); k.mu_v = *(const f32x4*)(p.mu + 1024 + colb);
        k.kk_c = *(const f32x4*)(p.k_k + colb); k.ka_c = *(const f32x4*)(p.k_a + colb); k.rk_c = *(const f32x4*)(p.r_k + colb); k.lnw = *(const f32x4*)(p.ln_w + colb); k.lnb = *(const f32x4*)(p.ln_b + colb);
        const int t0 = 8 * sw + tq, t1 = t0 + 4;
        { const ScanRaw a0 = scan_load_raw(p, 0, t0, b, colb), a1 = scan_load_raw(p, 0, t1, b, colb);
          scan_stage_write(p, a0, k, lds, 0, 0, t0, b, colb, cg); scan_stage_write(p, a1, k, lds, 0, 0, t1, b, colb, cg); }
        ScanRaw c0 = scan_load_raw(p, 1, t0, b, colb), c1 = scan_load_raw(p, 1, t1, b, colb);
        for (int ch = 0; ch < SC_NCH; ++ch) {
            __syncthreads();
            ScanRaw n0 = c0, n1 = c1;
            if (ch + 2 < SC_NCH) { n0 = scan_load_raw(p, ch + 2, t0, b, colb); n1 = scan_load_raw(p, ch + 2, t1, b, colb); }
            u32x2 g0 = {0u, 0u}, g1 = {0u, 0u}; ScanPost q0, q1;
            if (ch >= 1) {
                const size_t rowp = (size_t)b * SEQ + (ch - 1) * SC_T;
                g0 = *(const u32x2*)(p.low + (rowp + t0) * 2048 + 1024 + colb); g1 = *(const u32x2*)(p.low + (rowp + t1) * 2048 + 1024 + colb);
                q0 = scan_post_read(lds, ((ch - 1) & 1) * SC_BUF, t0, cg); q1 = scan_post_read(lds, ((ch - 1) & 1) * SC_BUF, t1, cg);
            }
            if (ch + 1 < SC_NCH) { scan_stage_write(p, c0, k, lds, ((ch + 1) & 1) * SC_BUF, ch + 1, t0, b, colb, cg); scan_stage_write(p, c1, k, lds, ((ch + 1) & 1) * SC_BUF, ch + 1, t1, b, colb, cg); }
            if (ch >= 1) { scan_post_finish(p, q0, g0, k, ch - 1, t0, b, colb); scan_post_finish(p, q1, g1, k, ch - 1, t1, b, colb); }
            c0 = n0; c1 = n1;
        }
        __syncthreads();
        { const size_t rowp = (size_t)b * SEQ + (SC_NCH - 1) * SC_T; const int bo = ((SC_NCH - 1) & 1) * SC_BUF;
          const u32x2 g0 = *(const u32x2*)(p.low + (rowp + t0) * 2048 + 1024 + colb), g1 = *(const u32x2*)(p.low + (rowp + t1) * 2048 + 1024 + colb);
          const ScanPost q0 = scan_post_read(lds, bo, t0, cg), q1 = scan_post_read(lds, bo, t1, cg);
          scan_post_finish(p, q0, g0, k, SC_NCH - 1, t0, b, colb); scan_post_finish(p, q1, g1, k, SC_NCH - 1, t1, b, colb); }
    } else {
        const int kq = lane & 3, r0 = wid * 16 + (lane >> 2);
        f32x2 S[8];
#pragma unroll
        for (int i = 0; i < 8; ++i) { S[i].x = 0.f; S[i].y = 0.f; }
        for (int ch = 0; ch < SC_NCH; ++ch) {
            __syncthreads();
            LAS unsigned char* bb = lds + (ch & 1) * SC_BUF;
            StepIn A = scan_ld_step(bb, 0, kq, r0), B;
#pragma unroll
            for (int t = 0; t < SC_T; t += 2) {
                B = scan_ld_step(bb, t + 1, kq, r0);
                scan_do_step(S, A, bb, t, kq, r0);
                if (t + 2 < SC_T) A = scan_ld_step(bb, t + 2, kq, r0);
                scan_do_step(S, B, bb, t + 1, kq, r0);
            }
        }
        __syncthreads();
    }
    __syncthreads();
}

#define GEMM_PHASE_ROT_A(EpiT, g, e, rot, ALIGN) do { NEWCTX(); pg8::StaticOrder S_; S_.init((g).M, (g).N, c.nblk, (c.bid + c.nblk - (rot)) % c.nblk); pg8::gemm_phase<EpiT, pg8::StaticOrder, ALIGN, true>(c.lds, (g), S_, (e), c.tid); } while (0)
#define GEMM_PHASE_ROT(EpiT, g, e, rot) GEMM_PHASE_ROT_A(EpiT, g, e, rot, true)
#define GEMM_PHASE(EpiT, g, e) GEMM_PHASE_ROT(EpiT, g, e, 0)

typedef pg8::EpiResidual<true, false> EPI_T0; typedef pg8::EpiResidual<false, false> EPI_T1;
__global__ void __launch_bounds__(NTHREADS, 2) fwd_megakernel(Args a_unused) {
    extern __shared__ __attribute__((aligned(16))) unsigned char lds_raw[];
    cg::grid_group grid = cg::this_grid();
    Ctx c;
    const int wave_s = __builtin_amdgcn_readfirstlane((int)threadIdx.x >> 6);
    ArgsP ap; unsigned char* ws; float* hout; const float* xin; bf16* XN; unsigned* ctl;
#define NEWCTX() do { int l_; asm volatile("v_mbcnt_lo_u32_b32 %0, -1, 0\n\tv_mbcnt_hi_u32_b32 %0, -1, %0" : "=v"(l_)); \
        ap = (ArgsP)__builtin_amdgcn_kernarg_segment_ptr(); asm volatile("" : "+s"(ap)); \
        { int b_ = blockIdx.x, n_ = gridDim.x, w_ = wave_s; asm volatile("" : "+s"(b_), "+s"(n_), "+s"(w_)); c.bid = b_; c.nblk = n_; c.wave = w_; } \
        c.lane = l_; c.tid = c.wave * 64 + l_; c.gw = c.bid * NWAVES + c.wave; c.ngw = c.nblk * NWAVES; c.lds = (LAS unsigned char*)lds_raw; \
        ws = ap->ws; hout = ap->out; xin = (const float*)ap->in[0]; XN = (bf16*)hout;     ctl = (unsigned*)(ws + WS_CTL); } while (0)
    NEWCTX();
    volatile LAS unsigned* bar_st = (volatile LAS unsigned*)(lds_raw + 131072 + 64);
    if (c.tid < 2) bar_st[c.tid] = 0u;
    __syncthreads();
    xcd_barrier_post((unsigned*)(ws + WS_CTL + CTL_BAR), c.tid);
#define SYNC() do { NEWCTX(); xcd_barrier((unsigned*)(ws + WS_CTL + CTL_BAR), bar_st, c.tid, (unsigned)c.nblk); NEWCTX(); } while (0)
#define SS(i) ((float*)(ws + WS_SSP))

    { const float* mem = (const float*)ap->in[1]; const float* mg = (const float*)ap->in[27]; bf16* memn = (bf16*)(ws + WS_MEMN);
      for (int row = c.gw; row < MMEM; row += c.ngw) rms_row_to_bf16(mem + (size_t)row * 1024, mg, memn + (size_t)row * 1024, c.lane); }
    { float* __restrict__ ss0 = SS(0);
#pragma unroll 4
      for (int row = c.gw; row < MTOK; row += c.ngw) {
          const f32x4* __restrict__ xr = (const f32x4*)(xin + (size_t)row * 1024) + c.lane; unsigned long long* __restrict__ o8 = (unsigned long long*)(XN + (size_t)row * 1024) + c.lane;
          float s = 0.f;
#pragma unroll
          for (int j = 0; j < 4; ++j) { const f32x4 v = xr[64 * j]; s += (v.x * v.x + v.y * v.y) + (v.z * v.z + v.w * v.w);
              o8[64 * j] = (unsigned long long)pk2(v.x, v.y) | ((unsigned long long)pk2(v.z, v.w) << 32); }
          s = wave_sum(s, c.lane);
          if (c.lane < 16) ss0[(size_t)row * 16 + c.lane] = c.lane == 0 ? s : 0.f;
      } }
    convert_weights<0>(c, ap, ws, 0);
    grid.sync(); NEWCTX();

    for (int l = 0; l < DEPTH; ++l) {
        { pg8::Gemm g = pg8::mk_gemm(XN, (const bf16*)(ws + W_IN), MTOK, l == 0 ? 2048 : 2304, 1024);
          pg8::EpiBf16<0> e = pg8::mk_epi_bf16((bf16*)(ws + WS_PROJ), 2048, 1.0f); e.c2_lo = 2048; e.c2_hi = 2080; e.O2 = (bf16*)(ws + WS_PROJ2); e.ldc2 = 32; e.ss = SS(3 * l);
          GEMM_PHASE(pg8::EpiBf16<0>, g, e); }
        SYNC();
        prep_pass(c, ap, ws, l);
        convert_weights<1>(c, ap, ws, l);
        SYNC();
        { pg8::Gemm g = pg8::mk_gemm((const bf16*)(ws + WS_CQN), (const bf16*)(ws + W_UQ), MTOK, 768, 256);
          pg8::EpiQRope e; e.O = (bf16*)(ws + WS_Q); e.pos = (const int*)ap->in[2]; e.scale = MLA_QSCALE; GEMM_PHASE(pg8::EpiQRope, g, e); }
        { pg8::Gemm g = pg8::mk_gemm((const bf16*)(ws + WS_CKVN), (const bf16*)(ws + W_KN), MTOK, 512, 128);
          pg8::EpiBf16<0> e = pg8::mk_epi_bf16((bf16*)(ws + WS_KN), 512, 1.0f); GEMM_PHASE(pg8::EpiBf16<0>, g, e); }
        { pg8::Gemm g = pg8::mk_gemm((const bf16*)(ws + W_VT), (const bf16*)(ws + WS_CKVN), 512, MTOK, 128);
          pg8::EpiVT e; e.O = (bf16*)(ws + WS_VT); GEMM_PHASE(pg8::EpiVT, g, e); }
        { pg8::Gemm g = pg8::mk_gemm((const bf16*)(ws + WS_ALR), (const bf16*)(ws + W_LR), MTOK, l == 0 ? 1536 : 2048, 256);
          pg8::EpiLowrank e; e.O = (bf16*)(ws + WS_LOW); e.w0 = (const float*)ap->in[13] + l * 512; e.a0 = (const float*)ap->in[15] + l * 512; e.v0 = l > 0 ? (const float*)ap->in[18] + (l - 1) * 512 : (const float*)ap->in[15];
          GEMM_PHASE(pg8::EpiLowrank, g, e); }
        { pg8::Gemm g = pg8::mk_gemm((const bf16*)(ws + WS_MEMN), (const bf16*)(ws + W_CKV), MMEM, 2048, 1024);
          pg8::EpiBf16<0> e = pg8::mk_epi_bf16((bf16*)(ws + WS_MEMKV), 2048, 1.0f); GEMM_PHASE_ROT(pg8::EpiBf16<0>, g, e, 128); }
        SYNC();
        if (c.bid < 128) {
            ScanP p; p.proj = (const bf16*)(ws + WS_PROJ); p.low = (const bf16*)(ws + WS_LOW); p.vfirst = (bf16*)(ws + WS_VFIRST); p.mix = (bf16*)(ws + WS_MIX);
            p.mu = l == 0 ? (const float*)ap->in[6] : (const float*)ap->in[7] + (size_t)(l - 1) * 1728;
            p.k_k = (const float*)ap->in[20] + l * 512; p.k_a = (const float*)ap->in[21] + l * 512; p.r_k = (const float*)ap->in[22] + l * 512;
            p.ln_w = (const float*)ap->in[23] + l * 512; p.ln_b = (const float*)ap->in[24] + l * 512; p.layer = l;
            scan_unit(c, p, c.bid >> 3, c.bid & 7);
        }
        { const float* onorm = (const float*)ap->in[12] + l * 512; LAS unsigned* uw = (LAS unsigned*)(c.lds + AT_CTRL);
          for (;;) {
              if (c.tid == 0) *uw = atomicAdd(ctl + 64 * l, 1u);
              __syncthreads();
              const unsigned u = *uw;
              __syncthreads();
              if (u >= 2048u) break;
              const int qb = 15 - (int)(u >> 7), bh = (int)(u & 127);
              mla_attn_unit(c, ws, onorm, bh >> 3, bh & 7, qb);
          } }
        SYNC();
        { pg8::Gemm g = pg8::mk_gemm((const bf16*)(ws + WS_MIX), (const bf16*)(ws + W_OUT), MTOK, 1024, 1024);
          if (l == 0) { pg8::EpiResidual<true, false> e; e.basef = xin; e.baseh = XN; e.outf = nullptr; e.outh = XN; e.ss = SS(1); GEMM_PHASE(EPI_T0, g, e); }
          else { pg8::EpiResidual<false, false> e; e.basef = nullptr; e.baseh = XN; e.outf = nullptr; e.outh = XN; e.ss = SS(3 * l + 1); GEMM_PHASE(EPI_T1, g, e); } }
        { pg8::Gemm g = pg8::mk_gemm((const bf16*)(ws + WS_MEMKV), (const bf16*)(ws + W_CQ), 64 * 256, 1024, 256); g.lda = 2048; g.ldb = 1024;
          g.a_d = 4; g.a_hi = (long)256 * 2048 * 2; g.a_lo = 512; g.b_pn = (long)256 * 1024 * 2; g.b_pmod = 4; g.b_pmo = 512;
          pg8::EpiBf16<0> e = pg8::mk_epi_bf16((bf16*)(ws + WS_WKT), 1024, 1.0f); GEMM_PHASE(pg8::EpiBf16<0>, g, e); }
        { pg8::Gemm g = pg8::mk_gemm((const bf16*)(ws + W_CO), (const bf16*)(ws + WS_MEMKV) + 1024, 64 * 256, 1024, 256); g.lda = 1024; g.ldb = 2048;
          g.a_d = 4; g.a_hi = 0; g.a_lo = (long)256 * 1024 * 2; g.a_pn = 512; g.b_pn = 512; g.tpb = 4; g.b_bt = (long)256 * 2048 * 2;
          pg8::EpiBf16<0> e = pg8::mk_epi_bf16((bf16*)(ws + WS_VWT), 1024, 1.0f); GEMM_PHASE(pg8::EpiBf16<0>, g, e); }
        SYNC();
        { pg8::Gemm g = pg8::mk_gemm(XN, (const bf16*)(ws + WS_WKT), MTOK, 1024, 1024); g.tpb = 16; g.b_bt = (long)1024 * 1024 * 2;
          pg8::EpiSoftmax e; e.P = (bf16*)(ws + WS_P); e.xm = (LAS float*)(c.lds + 131072 + 1024); e.xs = (LAS float*)(c.lds + 131072 + 1024 + 4096); e.ss = SS(3 * l + 1); e.scale = CA_QSCALE;
          GEMM_PHASE(pg8::EpiSoftmax, g, e); }
        SYNC();
        { pg8::Gemm g = pg8::mk_gemm((const bf16*)(ws + WS_P), (const bf16*)(ws + WS_VWT), MTOK, 1024, 1024); g.tpb = 16; g.b_bt = (long)1024 * 1024 * 2;
          pg8::EpiResidual<false, false> e; e.basef = nullptr; e.baseh = XN; e.outf = nullptr; e.outh = XN; e.ss = SS(3 * l + 2); GEMM_PHASE(EPI_T1, g, e); }
        SYNC();
        if (l + 1 < DEPTH) convert_weights<0>(c, ap, ws, l + 1);
        LDS_WAIT(); __syncthreads();
        { pg8::Gemm g = pg8::mk_gemm(XN, (const bf16*)(ws + W_UP), MTOK, DFF, 1024);
          pg8::EpiBf16<1> e; e.O = (bf16*)(ws + WS_HID); e.ldc = DFF; e.scale = 1.0f; e.c2_lo = 1 << 30; e.c2_hi = 1 << 30; e.O2 = e.O; e.ldc2 = 0; e.ss = SS(3 * l + 2); GEMM_PHASE(pg8::EpiBf16<1>, g, e); }
        SYNC();
        { pg8::Gemm g = pg8::mk_gemm((const bf16*)(ws + WS_HID), (const bf16*)(ws + W_DN), MTOK, 1024, DFF);
          pg8::EpiResidual<false, false> e; e.basef = nullptr; e.baseh = XN; e.outf = nullptr; e.outh = l + 1 < DEPTH ? XN : (bf16*)(ws + WS_HF32); e.ss = SS(3 * l + 3); GEMM_PHASE(EPI_T1, g, e); }
        SYNC();
    }
    { const float* g = (const float*)ap->in[34]; const float* ssf = SS(3 * DEPTH); const bf16* hf = (const bf16*)(ws + WS_HF32);
#pragma unroll 4
      for (int row = c.gw; row < MTOK; row += c.ngw) {
          const u32x2* __restrict__ xr = (const u32x2*)(hf + (size_t)row * 1024) + c.lane; f32x4* __restrict__ orow = (f32x4*)(hout + (size_t)row * 1024) + c.lane; const f32x4* __restrict__ gr = (const f32x4*)g + c.lane;
          float sp = c.lane < 16 ? ssf[(size_t)row * 16 + c.lane] : 0.f; sp = wave_sum(sp, c.lane);
          const float rs = 1.0f / sqrtf(sp * (1.0f / 1024.0f) + EPS);
#pragma unroll
          for (int j = 0; j < 4; ++j) { const u32x2 w = xr[64 * j]; f32x4 v; v.x = bflo(w.x); v.y = bfhi(w.x); v.z = bflo(w.y); v.w = bfhi(w.y); orow[64 * j] = v * rs * gr[64 * j]; }
      } }
}

extern "C" void kernel_launch(void* const* d_in, const int* in_sizes, int n_in, void* d_out, int out_size, void* d_ws, size_t ws_size, hipStream_t stream) {
    static int grid = 0;
    if (grid == 0) {
        if (n_in != 35 || out_size != MTOK * DM || ws_size < WS_NEED) { fprintf(stderr, "kernel_launch: unexpected shapes (n_in %d out %d ws %zu)\n", n_in, out_size, ws_size); grid = -1; return; }
        int dev = 0, cus = 0, per_cu = 0;
        hipGetDevice(&dev); hipDeviceGetAttribute(&cus, hipDeviceAttributeMultiprocessorCount, dev);
        hipFuncSetAttribute((const void*)fwd_megakernel, hipFuncAttributeMaxDynamicSharedMemorySize, LDS_BYTES);
        hipOccupancyMaxActiveBlocksPerMultiprocessor(&per_cu, (const void*)fwd_megakernel, NTHREADS, LDS_BYTES);
        (void)hipGetLastError();
        if (per_cu < 1) per_cu = 1;
        grid = cus * 1;
        if (grid < 128) { fprintf(stderr, "kernel_launch: grid %d too small\n", grid); grid = -1; return; }
    }
    if (grid < 0) return;
    hipMemsetAsync((char*)d_ws + WS_CTL, 0, CTL_BYTES, stream);
    Args a{};
    for (int i = 0; i < 35; ++i) a.in[i] = d_in[i];
    a.out = (float*)d_out; a.ws = (unsigned char*)d_ws;
    void* params[] = {&a};
    hipError_t e = hipLaunchCooperativeKernel((const void*)fwd_megakernel, dim3(grid), dim3(NTHREADS), params, LDS_BYTES, stream);
    if (e != hipSuccess) fprintf(stderr, "cooperative launch failed: %s (grid %d)\n", hipGetErrorString(e), grid);
}
```

```cpp
#include <hip/hip_runtime.h>
#include <hip/hip_cooperative_groups.h>
#include <cstdint>
#include <cstdio>
namespace cg = cooperative_groups;
namespace pg8 {
#define PG8_LAS __attribute__((address_space(3)))
typedef unsigned short bf16_t;
typedef short bf16x8 __attribute__((ext_vector_type(8)));
typedef float f32x4 __attribute__((ext_vector_type(4)));
typedef unsigned u32x4 __attribute__((ext_vector_type(4)));
constexpr int BM = 256, BK = 64, HALF = 128, HTB = HALF * BK * 2  , STAGE_BYTES = 8 * HTB, NXCD = 8, WGM = 8;

__host__ __device__ __forceinline__ int lds_byte(int r, int c) { const int st = (r >> 4) * 2 + (c >> 5), rr = r & 15, cc = c & 31, ob = rr * 64 + cc * 2; return st * 1024 + (ob ^ (((ob >> 9) & 1) << 5)); }
__host__ __device__ __forceinline__ void stage_rc(int b, int& R, int& C) { const int st = b / 1024, sb = b % 1024, swz = sb ^ (((sb >> 9) & 1) << 5); R = (st >> 1) * 16 + swz / 64; C = (st & 1) * 32 + (swz % 64) / 2; }
__host__ __device__ __forceinline__ int perm32(int rho) { const int n = rho >> 4, i = rho & 15; return 8 * (i >> 2) + 4 * n + (i & 3); }

struct Unit { int pm, pn; };

struct StaticOrder {
    int nM, nN, nwg, G, c;
    __host__ __device__ void init(int M, int N, int G_, int c_) { nM = M / BM; nN = N / BM; nwg = nM * nN; G = G_; c = c_; }
    __host__ __device__ bool next(int i, Unit& u) const {
        const long L = (long)i * G + c; if (L >= nwg) return false;
        int wgid = (int)L; { const int q = nwg / NXCD, r = nwg % NXCD, xcd = wgid % NXCD, off = wgid / NXCD; wgid = (xcd < r ? xcd * (q + 1) : r * (q + 1) + (xcd - r) * q) + off; }
        const int nig = WGM * nN, gid = wgid / nig, fm = gid * WGM, gsz = (nM - fm) < WGM ? (nM - fm) : WGM;
        u.pm = fm + ((wgid % nig) % gsz); u.pn = (wgid % nig) / gsz; return true;
    }
    __device__ __forceinline__ void a_ready(const Unit&) const {}
    __device__ __forceinline__ void done(const Unit&) const {}
};

struct Gemm { const bf16_t* A; const bf16_t* Bt; int M, N, K, lda, ldb; long a_hi, a_lo, a_pn, a_pn2, b_pn, b_bt, b_pmo; int a_d, a_sh, tpb, b_pmod;
    __device__ __forceinline__ const char* uA(const Unit& u) const { return (const char*)A + (size_t)(u.pm / a_d) * a_hi + (size_t)(u.pm % a_d) * a_lo + (size_t)u.pn * a_pn + (size_t)(u.pn >> a_sh) * a_pn2; }
    __device__ __forceinline__ const char* uB(const Unit& u) const { return (const char*)Bt + (size_t)u.pn * b_pn + (size_t)(u.pm / tpb) * b_bt + (size_t)(u.pm % b_pmod) * b_pmo; } };
__device__ __forceinline__ Gemm mk_gemm(const bf16_t* A, const bf16_t* Bt, int M, int N, int K) { Gemm g; g.A = A; g.Bt = Bt; g.M = M; g.N = N; g.K = K; g.lda = K; g.ldb = K; g.a_hi = 0; g.a_lo = (long)512 * K; g.a_d = 1 << 30; g.a_pn = 0; g.a_pn2 = 0; g.a_sh = 0;
    g.b_pn = (long)512 * K; g.b_bt = 0; g.tpb = 1 << 30; g.b_pmo = 0; g.b_pmod = 1; return g; }

__device__ __forceinline__ unsigned cvt_pk_bf16(float lo, float hi) { unsigned r; asm volatile("v_cvt_pk_bf16_f32 %0, %1, %2" : "=v"(r) : "v"(lo), "v"(hi)); return r; }
typedef float f32x2 __attribute__((ext_vector_type(2)));
typedef unsigned u32x2 __attribute__((ext_vector_type(2)));

__constant__ float ROPE_INV[16] = {1.000000000e+00f, 5.623413252e-01f, 3.162277660e-01f, 1.778279410e-01f, 1.000000000e-01f, 5.623413252e-02f, 3.162277660e-02f, 1.778279410e-02f,
                                   1.000000000e-02f, 5.623413252e-03f, 3.162277660e-03f, 1.778279410e-03f, 1.000000000e-03f, 5.623413252e-04f, 3.162277660e-04f, 1.778279410e-04f};
__device__ __forceinline__ void rope_cs(int pos, int i, float& c, float& s) {
    double t = (double)pos * (double)ROPE_INV[i] * 0.15915494309189535;
    t -= __builtin_rint(t);
    const float tf = (float)t;
    c = __builtin_amdgcn_cosf(tf); s = __builtin_amdgcn_sinf(tf);
}
__device__ __forceinline__ float sigmoidf_(float x) { return 1.0f / (1.0f + __expf(-x)); }

template <int ACT> struct EpiBf16 {
    static constexpr bool PERM = true, AFTER_DRAIN = false;
    bf16_t* O; long ldc; float scale; int c2_lo, c2_hi; bf16_t* O2; long ldc2; const float* ss;
    __device__ __forceinline__ void operator()(const f32x4 (&acc)[2][2][4][2], const Unit& u, int wr, int wc, int fr, int fq) const {
        const int row0 = u.pm * BM + wr * 64 + fr; const int col0 = u.pn * BM + wc * 32 + 8 * fq;
#pragma unroll
        for (int ai = 0; ai < 2; ++ai)
#pragma unroll
            for (int m = 0; m < 4; ++m) { const long row = row0 + ai * HALF + m * 16; float rsc = scale; if (ss) { const f32x4* pp = (const f32x4*)(ss + row * 16); const f32x4 a0 = pp[0], a1 = pp[1], a2 = pp[2], a3 = pp[3]; const f32x4 t = (a0 + a1) + (a2 + a3); rsc = scale * (1.0f / sqrtf(((t[0] + t[1]) + (t[2] + t[3])) * (1.0f / 1024.0f) + 1e-6f)); }
#pragma unroll
                for (int bj = 0; bj < 2; ++bj) { f32x4 v0 = acc[ai][bj][m][0] * rsc, v1 = acc[ai][bj][m][1] * rsc; const int col = col0 + bj * HALF;
                    if (ACT == 1) {
#pragma unroll
                        for (int j = 0; j < 4; ++j) { float a = fmaxf(v0[j], 0.f), b = fmaxf(v1[j], 0.f); v0[j] = a * a; v1[j] = b * b; } }
                    u32x4 w; w.x = cvt_pk_bf16(v0[0], v0[1]); w.y = cvt_pk_bf16(v0[2], v0[3]); w.z = cvt_pk_bf16(v1[0], v1[1]); w.w = cvt_pk_bf16(v1[2], v1[3]);
                    if (col < c2_lo) *(u32x4*)(O + row * ldc + col) = w;
                    else if (col < c2_hi) *(u32x4*)(O2 + row * ldc2 + (col - c2_lo)) = w; } }
    }
};
__device__ __forceinline__ EpiBf16<0> mk_epi_bf16(bf16_t* O, long ldc, float scale) { EpiBf16<0> e; e.O = O; e.ldc = ldc; e.scale = scale; e.c2_lo = 1 << 30; e.c2_hi = 1 << 30; e.O2 = O; e.ldc2 = 0; e.ss = nullptr; return e; }


struct EpiVT {
    static constexpr bool PERM = true, AFTER_DRAIN = false;
    bf16_t* O;
    __device__ __forceinline__ void operator()(const f32x4 (&acc)[2][2][4][2], const Unit& u, int wr, int wc, int fr, int fq) const {
        const int row0 = u.pm * BM + wr * 64 + fr; const int col0 = u.pn * BM + wc * 32 + 8 * fq;
#pragma unroll
        for (int ai = 0; ai < 2; ++ai)
#pragma unroll
            for (int m = 0; m < 4; ++m) { const int f = row0 + ai * HALF + m * 16;
#pragma unroll
                for (int bj = 0; bj < 2; ++bj) { const f32x4 v0 = acc[ai][bj][m][0], v1 = acc[ai][bj][m][1]; const int tok = col0 + bj * HALF;
                    u32x4 w; w.x = cvt_pk_bf16(v0[0], v0[1]); w.y = cvt_pk_bf16(v0[2], v0[3]); w.z = cvt_pk_bf16(v1[0], v1[1]); w.w = cvt_pk_bf16(v1[2], v1[3]);
                    const size_t idx = ((size_t)(((tok >> 12) * 8 + (f >> 6)) * 64 + ((tok & 4095) >> 6)) << 12) + (size_t)((f & 63) * 64 + (tok & 63));
                    *(u32x4*)(O + idx) = w; } }
    }
};

struct EpiQRope {
    static constexpr bool PERM = false, AFTER_DRAIN = false;
    bf16_t* O; const int* pos; float scale;
    __device__ __forceinline__ void operator()(const f32x4 (&acc)[2][2][4][2], const Unit& u, int wr, int wc, int fr, int fq) const {
#pragma unroll
        for (int bj = 0; bj < 2; ++bj) { const int cbase = u.pn * BM + bj * HALF + wc * 32; const bool is_rope = ((cbase >> 5) % 3) == 2;
#pragma unroll
            for (int ai = 0; ai < 2; ++ai)
#pragma unroll
                for (int m = 0; m < 4; ++m) { const long row = u.pm * BM + ai * HALF + wr * 64 + m * 16 + fr; f32x4 v0 = acc[ai][bj][m][0], v1 = acc[ai][bj][m][1];
                    if (is_rope) { const int p = pos[row];
#pragma unroll
                        for (int j = 0; j < 4; ++j) { float c, s; rope_cs(p, 4 * fq + j, c, s); const float a = v0[j], b = v1[j]; v0[j] = a * c - b * s; v1[j] = a * s + b * c; } }
                    v0 = v0 * scale; v1 = v1 * scale;
                    u32x2 w0, w1; w0.x = cvt_pk_bf16(v0[0], v0[1]); w0.y = cvt_pk_bf16(v0[2], v0[3]); w1.x = cvt_pk_bf16(v1[0], v1[1]); w1.y = cvt_pk_bf16(v1[2], v1[3]);
                    bf16_t* p0 = O + row * 768 + cbase + 4 * fq; *(u32x2*)p0 = w0; *(u32x2*)(p0 + 16) = w1; } }
    }
};

struct EpiLowrank {
    static constexpr bool PERM = true, AFTER_DRAIN = false;
    bf16_t* O; const float* w0; const float* a0; const float* v0;
    __device__ __forceinline__ void operator()(const f32x4 (&acc)[2][2][4][2], const Unit& u, int wr, int wc, int fr, int fq) const {
        asm volatile("" : "+v"(fr), "+v"(fq));
        const int row0 = u.pm * BM + wr * 64 + fr; const int col0 = u.pn * BM + wc * 32 + 8 * fq; const int kind = u.pn >> 1;
#pragma unroll
        for (int bj = 0; bj < 2; ++bj) { const int col = col0 + bj * HALF; const int c5 = col & 511;
            float bias[8];
#pragma unroll
            for (int j = 0; j < 8; ++j) bias[j] = kind == 0 ? w0[c5 + j] : kind == 1 ? a0[c5 + j] : kind == 3 ? v0[c5 + j] : 0.f;
#pragma unroll
            for (int ai = 0; ai < 2; ++ai)
#pragma unroll
                for (int m = 0; m < 4; ++m) { const long row = row0 + ai * HALF + m * 16; float v[8];
#pragma unroll
                    for (int j = 0; j < 4; ++j) { v[j] = acc[ai][bj][m][0][j] + bias[j]; v[4 + j] = acc[ai][bj][m][1][j] + bias[4 + j]; }
#pragma unroll
                    for (int j = 0; j < 8; ++j) {
                        if (kind == 0) { v[j] = -0.87503877f * __builtin_amdgcn_rcpf(1.0f + __expf(-v[j])); }
                        else if (kind == 1 || kind == 3) v[j] = sigmoidf_(v[j]);
                    }
                    u32x4 w; w.x = cvt_pk_bf16(v[0], v[1]); w.y = cvt_pk_bf16(v[2], v[3]); w.z = cvt_pk_bf16(v[4], v[5]); w.w = cvt_pk_bf16(v[6], v[7]);
                    *(u32x4*)(O + row * 2048 + col) = w; } }
    }
};

template <bool BASE_F32, bool OUT_F32> struct EpiResidual {
    static constexpr bool PERM = false, AFTER_DRAIN = false;
    const float* basef; const bf16_t* baseh; float* outf; bf16_t* outh; float* ss;
    __device__ __forceinline__ void operator()(const f32x4 (&acc)[2][2][4][2], const Unit& u, int wr, int wc, int fr, int fq) const {
        asm volatile("" : "+v"(fr), "+v"(fq));
        const int lane = fq * 16 + fr; const int colb = u.pn * BM + wc * 32 + 4 * fq;
#pragma unroll
        for (int ai = 0; ai < 2; ++ai)
#pragma unroll
            for (int m = 0; m < 4; ++m) { const int row = u.pm * BM + ai * HALF + wr * 64 + m * 16 + fr; const size_t off = (size_t)row * 1024 + colb; float s = 0.f;
#pragma unroll
                for (int bj = 0; bj < 2; ++bj)
#pragma unroll
                    for (int n = 0; n < 2; ++n) { const size_t o = off + bj * HALF + n * 16; f32x4 b;
                        if (BASE_F32) b = *(const f32x4*)(basef + o);
                        else { const u32x2 w = *(const u32x2*)(baseh + o); b[0] = __builtin_bit_cast(float, w.x << 16); b[1] = __builtin_bit_cast(float, w.x & 0xffff0000u); b[2] = __builtin_bit_cast(float, w.y << 16); b[3] = __builtin_bit_cast(float, w.y & 0xffff0000u); }
                        const f32x4 v = b + acc[ai][bj][m][n];
                        s += (v[0] * v[0] + v[1] * v[1]) + (v[2] * v[2] + v[3] * v[3]);
                        if (OUT_F32) *(f32x4*)(outf + o) = v;
                        else { u32x2 w; w.x = cvt_pk_bf16(v[0], v[1]); w.y = cvt_pk_bf16(v[2], v[3]); *(u32x2*)(outh + o) = w; } }
                s += __builtin_bit_cast(float, __builtin_amdgcn_ds_bpermute((lane ^ 16) << 2, __builtin_bit_cast(int, s)));
                s += __builtin_bit_cast(float, __builtin_amdgcn_ds_bpermute((lane ^ 32) << 2, __builtin_bit_cast(int, s)));
                if (fq == 0) ss[(size_t)row * 16 + u.pn * 4 + wc] = s; }
    }
};

struct EpiSoftmax {
    static constexpr bool PERM = true, AFTER_DRAIN = false;
    bf16_t* P; PG8_LAS float* xm; PG8_LAS float* xs; const float* ss; float scale;
    __device__ __forceinline__ void operator()(const f32x4 (&acc_c)[2][2][4][2], const Unit& u, int wr, int wc, int fr, int fq) const {
        f32x4 (&acc)[2][2][4][2] = const_cast<f32x4 (&)[2][2][4][2]>(acc_c);
        asm volatile("" : "+v"(fr), "+v"(fq));
        const int lane = fq * 16 + fr;
#pragma unroll
        for (int ai = 0; ai < 2; ++ai)
#pragma unroll
            for (int m = 0; m < 4; ++m) { float mx = -INFINITY;
                const f32x4* pp = (const f32x4*)(ss + ((size_t)u.pm * BM + ai * HALF + wr * 64 + m * 16 + fr) * 16); const f32x4 t4 = (pp[0] + pp[1]) + (pp[2] + pp[3]);
                const float rsc = scale * (1.0f / sqrtf(((t4[0] + t4[1]) + (t4[2] + t4[3])) * (1.0f / 1024.0f) + 1e-6f));
#pragma unroll
                for (int bj = 0; bj < 2; ++bj)
#pragma unroll
                    for (int n = 0; n < 2; ++n) { const f32x4 v = acc[ai][bj][m][n] * rsc; acc[ai][bj][m][n] = v; mx = fmaxf(mx, fmaxf(fmaxf(v[0], v[1]), fmaxf(v[2], v[3]))); }
                mx = fmaxf(mx, __builtin_bit_cast(float, __builtin_amdgcn_ds_bpermute((lane ^ 16) << 2, __builtin_bit_cast(int, mx))));
                mx = fmaxf(mx, __builtin_bit_cast(float, __builtin_amdgcn_ds_bpermute((lane ^ 32) << 2, __builtin_bit_cast(int, mx))));
                if (fq == 0) xm[(ai * HALF + wr * 64 + m * 16 + fr) * 4 + wc] = mx; }
        asm volatile("s_waitcnt lgkmcnt(0)" ::: "memory"); __builtin_amdgcn_s_barrier(); asm volatile("" ::: "memory");
#pragma unroll
        for (int ai = 0; ai < 2; ++ai)
#pragma unroll
            for (int m = 0; m < 4; ++m) { const int r = ai * HALF + wr * 64 + m * 16 + fr; const f32x4 q = *(const PG8_LAS f32x4*)(xm + r * 4);
                const float M = fmaxf(fmaxf(q[0], q[1]), fmaxf(q[2], q[3])); float s = 0.f;
#pragma unroll
                for (int bj = 0; bj < 2; ++bj)
#pragma unroll
                    for (int n = 0; n < 2; ++n) { f32x4 v = acc[ai][bj][m][n];
#pragma unroll
                        for (int j = 0; j < 4; ++j) v[j] = __builtin_amdgcn_exp2f(v[j] - M);
                        s += (v[0] + v[1]) + (v[2] + v[3]); acc[ai][bj][m][n] = v; }
                s += __builtin_bit_cast(float, __builtin_amdgcn_ds_bpermute((lane ^ 16) << 2, __builtin_bit_cast(int, s)));
                s += __builtin_bit_cast(float, __builtin_amdgcn_ds_bpermute((lane ^ 32) << 2, __builtin_bit_cast(int, s)));
                if (fq == 0) xs[r * 4 + wc] = s; }
        asm volatile("s_waitcnt lgkmcnt(0)" ::: "memory"); __builtin_amdgcn_s_barrier(); asm volatile("" ::: "memory");
        const int col0 = u.pn * BM + wc * 32 + 8 * fq;
#pragma unroll
        for (int ai = 0; ai < 2; ++ai)
#pragma unroll
            for (int m = 0; m < 4; ++m) { const int r = ai * HALF + wr * 64 + m * 16 + fr; const f32x4 q = *(const PG8_LAS f32x4*)(xs + r * 4);
                const float inv = 1.0f / ((q[0] + q[1]) + (q[2] + q[3])); const size_t row = (size_t)u.pm * BM + r;
#pragma unroll
                for (int bj = 0; bj < 2; ++bj) { const f32x4 v0 = acc[ai][bj][m][0] * inv, v1 = acc[ai][bj][m][1] * inv;
                    u32x4 w; w.x = cvt_pk_bf16(v0[0], v0[1]); w.y = cvt_pk_bf16(v0[2], v0[3]); w.z = cvt_pk_bf16(v1[0], v1[1]); w.w = cvt_pk_bf16(v1[2], v1[3]);
                    *(u32x4*)(P + row * 1024 + col0 + bj * HALF) = w; } }
        asm volatile("s_waitcnt lgkmcnt(0)" ::: "memory");
    }
};

struct EpiF32 {
    static constexpr bool PERM = false, AFTER_DRAIN = false;
    float* out; long ldc;
    __device__ __forceinline__ void operator()(const f32x4 (&acc)[2][2][4][2], const Unit& u, int wr, int wc, int fr, int fq) const {
#pragma unroll
        for (int ai = 0; ai < 2; ++ai)
#pragma unroll
            for (int m = 0; m < 4; ++m) { const size_t off = (size_t)(u.pm * BM + ai * HALF + wr * 64 + m * 16 + fr) * ldc + u.pn * BM + wc * 32 + 4 * fq;
#pragma unroll
                for (int bj = 0; bj < 2; ++bj)
#pragma unroll
                    for (int n = 0; n < 2; ++n) *(f32x4*)(out + off + bj * HALF + n * 16) = acc[ai][bj][m][n]; }
    }
};

template <class Epi, class Sched, bool ALIGN_EPI = false, bool SP2 = false>
__device__ __forceinline__ void gemm_phase(PG8_LAS unsigned char* lds, const Gemm g, const Sched& S, const Epi& E, int tid_in) {
    int tid_l = tid_in; asm volatile("" : "+v"(tid_l));
    const int tid = tid_l, wid = __builtin_amdgcn_readfirstlane(tid >> 6), lane = tid & 63, wr = wid >> 2, wc = wid & 3, fr = lane & 15, fq = lane >> 4;
    const int K = g.K, nt = K / BK;
    unsigned voffA[2], voffB[2];
#pragma unroll
    for (int i = 0; i < 2; ++i) { int R, C; stage_rc(tid * 16 + i * 8192, R, C); const int Rb = Epi::PERM ? ((R & ~31) + perm32(R & 31)) : R;
        voffA[i] = (unsigned)(R * g.lda + C) * 2u; voffB[i] = (unsigned)(Rb * g.ldb + C) * 2u; }
    const size_t kstep = (size_t)(BK * 2);
    const size_t hstepA = (size_t)HALF * g.lda * 2, hstepB = (size_t)HALF * g.ldb * 2;

    const unsigned ldsw = (unsigned)wid * 1024u;
    const int aoff = lds_byte(wr * 64 + fr, fq * 8), boff = lds_byte(wc * 32 + fr, fq * 8);
#define PG8_SA(b, h) (((b) * 2 + (h)) * HTB)
#define PG8_SB(b, h) ((4 + (b) * 2 + (h)) * HTB)
#define PG8_STAGE(bufoff, gbase, voff) do { _Pragma("unroll") for (int _i = 0; _i < 2; ++_i) \
        __builtin_amdgcn_global_load_lds((const unsigned*)((const char*)(gbase) + (voff)[_i]), (PG8_LAS unsigned*)(lds + (bufoff) + ldsw + _i * 8192), 16, 0, 0); } while (0)
#define PG8_LDA(dst, b, h) do { _Pragma("unroll") for (int m = 0; m < 4; ++m) _Pragma("unroll") for (int k = 0; k < 2; ++k) dst[m][k] = *(const PG8_LAS bf16x8*)(lds + PG8_SA(b, h) + aoff + m * 2048 + k * 1024); } while (0)
#define PG8_LDB(dst, b, h) do { _Pragma("unroll") for (int n = 0; n < 2; ++n) _Pragma("unroll") for (int k = 0; k < 2; ++k) dst[n][k] = *(const PG8_LAS bf16x8*)(lds + PG8_SB(b, h) + boff + n * 2048 + k * 1024); } while (0)
#define PG8_MMA(ai, bj, At, Bt) do { __builtin_amdgcn_s_setprio(1); _Pragma("unroll") for (int m = 0; m < 4; ++m) _Pragma("unroll") for (int n = 0; n < 2; ++n) _Pragma("unroll") for (int k = 0; k < 2; ++k) \
        acc[ai][bj][m][n] = __builtin_amdgcn_mfma_f32_16x16x32_bf16(Bt[n][k], At[m][k], acc[ai][bj][m][n], 0, 0, 0); __builtin_amdgcn_s_setprio(0); } while (0)
#define PG8_WAIT_V(n) asm volatile("s_waitcnt vmcnt(" #n ")" ::: "memory")
#define PG8_WAIT_L(n) asm volatile("s_waitcnt lgkmcnt(" #n ")" ::: "memory")
#define PG8_BAR __builtin_amdgcn_s_barrier()
#define PG8_SCHED __builtin_amdgcn_sched_barrier(0)
    Unit cur, nxt; int ui = 0;
    if (!S.next(0, cur)) return;
    f32x4 acc[2][2][4][2];
#pragma unroll
    for (int a = 0; a < 2; ++a)
#pragma unroll
        for (int b = 0; b < 2; ++b)
#pragma unroll
            for (int m = 0; m < 4; ++m)
#pragma unroll
                for (int n = 0; n < 2; ++n) acc[a][b][m][n] = (f32x4){0.f, 0.f, 0.f, 0.f};
    bf16x8 At[4][2], B0[2][2], B1[2][2];
    const char* cA = g.uA(cur); const char* cB = g.uB(cur);
    S.a_ready(cur);
    if constexpr (SP2) {
        PG8_STAGE(PG8_SB(0, 0), cB, voffB); PG8_STAGE(PG8_SB(0, 1), cB + hstepB, voffB); PG8_STAGE(PG8_SA(0, 0), cA, voffA); PG8_STAGE(PG8_SA(0, 1), cA + hstepA, voffA);
        if (wr == 1) PG8_BAR;
        PG8_WAIT_V(2); PG8_BAR;
        PG8_STAGE(PG8_SB(1, 0), cB + kstep, voffB); PG8_STAGE(PG8_SA(1, 0), cA + kstep, voffA); PG8_STAGE(PG8_SB(1, 1), cB + hstepB + kstep, voffB);
        PG8_WAIT_V(6); PG8_BAR;
    } else {
        PG8_STAGE(PG8_SB(0, 0), cB, voffB); PG8_STAGE(PG8_SA(0, 0), cA, voffA); PG8_STAGE(PG8_SB(0, 1), cB + hstepB, voffB); PG8_STAGE(PG8_SA(0, 1), cA + hstepA, voffA);
        if (wr == 1) PG8_BAR;
        PG8_WAIT_V(4); PG8_BAR;
        PG8_STAGE(PG8_SB(1, 0), cB + kstep, voffB); PG8_STAGE(PG8_SA(1, 0), cA + kstep, voffA); PG8_STAGE(PG8_SB(1, 1), cB + hstepB + kstep, voffB);
        PG8_WAIT_V(6); PG8_BAR;
    }
    for (;;) {
        const bool has_next = S.next(ui + 1, nxt);
        const char* nA = has_next ? g.uA(nxt) : cA; const char* nB = has_next ? g.uB(nxt) : cB;
        for (int t = 0; t < nt; t += 2) {
            const bool last = (t == nt - 2);
            const char* a1 = cA + (size_t)(t + 1) * kstep;
            const char* a2 = last ? nA : cA + (size_t)(t + 2) * kstep; const char* b2 = last ? nB : cB + (size_t)(t + 2) * kstep;
            const char* a3 = a2 + kstep; const char* b3 = b2 + kstep;
            if (last && has_next) S.a_ready(nxt);
            if constexpr (SP2) {
            PG8_LDB(B0, 0, 0); PG8_LDB(B1, 0, 1); PG8_SCHED; PG8_LDA(At, 0, 0); PG8_STAGE(PG8_SA(1, 1), a1 + hstepA, voffA);
            PG8_WAIT_V(8); PG8_WAIT_L(0); PG8_BAR; PG8_MMA(0, 0, At, B0); PG8_MMA(0, 1, At, B1); PG8_BAR; PG8_SCHED;
            PG8_LDA(At, 0, 1); PG8_STAGE(PG8_SB(0, 0), b2, voffB); PG8_STAGE(PG8_SB(0, 1), b2 + hstepB, voffB); PG8_STAGE(PG8_SA(0, 0), a2, voffA);
            PG8_WAIT_V(8); PG8_WAIT_L(0); PG8_BAR; PG8_MMA(1, 0, At, B0); PG8_MMA(1, 1, At, B1); PG8_BAR; PG8_SCHED;
            PG8_LDB(B0, 1, 0); PG8_LDB(B1, 1, 1); PG8_SCHED; PG8_LDA(At, 1, 0); PG8_STAGE(PG8_SA(0, 1), a2 + hstepA, voffA);
            PG8_WAIT_V(8); PG8_WAIT_L(0); PG8_BAR; PG8_MMA(0, 0, At, B0); PG8_MMA(0, 1, At, B1); PG8_BAR; PG8_SCHED;
            PG8_LDA(At, 1, 1); PG8_STAGE(PG8_SB(1, 0), b3, voffB); PG8_STAGE(PG8_SB(1, 1), b3 + hstepB, voffB); PG8_STAGE(PG8_SA(1, 0), a3, voffA);
            PG8_WAIT_V(8); PG8_WAIT_L(0); PG8_BAR; PG8_MMA(1, 0, At, B0); PG8_MMA(1, 1, At, B1); PG8_BAR; PG8_SCHED;
            } else {
            PG8_LDB(B0, 0, 0); PG8_SCHED; PG8_LDA(At, 0, 0); PG8_STAGE(PG8_SA(1, 1), a1 + hstepA, voffA);
            PG8_WAIT_L(8); PG8_BAR; PG8_WAIT_L(0); PG8_MMA(0, 0, At, B0); PG8_BAR; PG8_SCHED;
            PG8_LDB(B1, 0, 1); PG8_STAGE(PG8_SB(0, 0), b2, voffB);
            PG8_BAR; PG8_WAIT_L(0); PG8_MMA(0, 1, At, B1); PG8_BAR;
            PG8_LDA(At, 0, 1); PG8_STAGE(PG8_SA(0, 0), a2, voffA);
            PG8_BAR; PG8_WAIT_L(0); PG8_MMA(1, 0, At, B0); PG8_BAR; PG8_SCHED;
            PG8_STAGE(PG8_SB(0, 1), b2 + hstepB, voffB);
            PG8_WAIT_V(6); PG8_BAR; PG8_MMA(1, 1, At, B1); PG8_BAR;
            PG8_LDB(B0, 1, 0); PG8_SCHED; PG8_LDA(At, 1, 0); PG8_STAGE(PG8_SA(0, 1), a2 + hstepA, voffA);
            PG8_WAIT_L(8); PG8_BAR; PG8_WAIT_L(0); PG8_MMA(0, 0, At, B0); PG8_BAR; PG8_SCHED;
            PG8_LDB(B1, 1, 1); PG8_STAGE(PG8_SB(1, 0), b3, voffB);
            PG8_BAR; PG8_WAIT_L(0); PG8_MMA(0, 1, At, B1); PG8_BAR;
            PG8_LDA(At, 1, 1); PG8_STAGE(PG8_SA(1, 0), a3, voffA);
            PG8_BAR; PG8_WAIT_L(0); PG8_MMA(1, 0, At, B0); PG8_BAR; PG8_SCHED;
            PG8_STAGE(PG8_SB(1, 1), b3 + hstepB, voffB);
            PG8_WAIT_V(6); PG8_BAR; PG8_MMA(1, 1, At, B1); PG8_BAR;
            }
        }
        if constexpr (ALIGN_EPI) { if (wr == 0) PG8_BAR; }
        if constexpr (!Epi::AFTER_DRAIN) { E(acc, cur, wr, wc, fr, fq); S.done(cur); }
        if (!has_next) break;
#pragma unroll
        for (int a = 0; a < 2; ++a)
#pragma unroll
            for (int b = 0; b < 2; ++b)
#pragma unroll
                for (int m = 0; m < 4; ++m)
#pragma unroll
                    for (int n = 0; n < 2; ++n) acc[a][b][m][n] = (f32x4){0.f, 0.f, 0.f, 0.f};
        cur = nxt; cA = nA; cB = nB; ++ui;
        if constexpr (ALIGN_EPI) { if (wr == 1) PG8_BAR; }
    }
    PG8_WAIT_V(0);
    if constexpr (!ALIGN_EPI) { if (wr == 0) PG8_BAR; }
    PG8_BAR;
    if constexpr (Epi::AFTER_DRAIN) { E.fused(acc, cur, wr, wc, fr, fq, lds, wid, lane); S.done(cur); }
#undef PG8_SA
#undef PG8_SB
#undef PG8_STAGE
#undef PG8_LDA
#undef PG8_LDB
#undef PG8_MMA
#undef PG8_WAIT_V
#undef PG8_WAIT_L
#undef PG8_BAR
#undef PG8_SCHED
}
}

#define LAS __attribute__((address_space(3)))
typedef unsigned short bf16;
typedef float f32x4 __attribute__((ext_vector_type(4)));
typedef float f32x16 __attribute__((ext_vector_type(16)));
typedef short bf16x8 __attribute__((ext_vector_type(8)));
typedef short s16x4 __attribute__((ext_vector_type(4)));
typedef unsigned u32x4 __attribute__((ext_vector_type(4)));
typedef unsigned u32x2 __attribute__((ext_vector_type(2)));

constexpr int NB = 16, SEQ = 4096, DM = 1024, DEPTH = 4, MEMLEN = 256;
constexpr int MTOK = NB * SEQ;
constexpr int MMEM = NB * MEMLEN;
constexpr int MLA_COLS = 352, RW = 512;
constexpr int IN0 = 2048, IN1 = 2080;
constexpr int DFF = 4096;
constexpr float EPS = 1e-6f, GN_EPS = 64e-5f;
constexpr float LOG2E = 1.4426950408889634f;
constexpr float MLA_QSCALE = 0.14724444602590306f;
constexpr float CA_QSCALE = 0.09016844005556021f;
constexpr int NTHREADS = 512, NWAVES = 8;
constexpr int LDS_BYTES = 147456;

constexpr size_t MiB = 1u << 20;
constexpr size_t WS_CTL = 0, CTL_BYTES = 1 * MiB;
constexpr size_t CTL_BAR = 4096, CTL_SS = 65536;
static_assert(CTL_SS + 3 * (size_t)MTOK * 4 <= CTL_BYTES, "ctl");
constexpr size_t WS_W = 1 * MiB;
constexpr size_t W_IN = WS_W;
constexpr size_t W_UQ = W_IN + (size_t)2304 * 1024 * 2;
constexpr size_t W_KN = W_UQ + (size_t)768 * 256 * 2;
constexpr size_t W_VT = W_KN + (size_t)512 * 128 * 2;
constexpr size_t W_LR = W_VT + (size_t)512 * 128 * 2;
constexpr size_t W_OUT = W_LR + (size_t)2048 * 256 * 2;
constexpr size_t W_CQ = W_OUT + (size_t)1024 * 1024 * 2;
constexpr size_t W_CKV = W_CQ + (size_t)1024 * 1024 * 2;
constexpr size_t W_CO = W_CKV + (size_t)2048 * 1024 * 2;
constexpr size_t W_UP = W_CO + (size_t)1024 * 1024 * 2;
constexpr size_t W_DN = W_UP + (size_t)4096 * 1024 * 2;
constexpr size_t W_END = W_DN + (size_t)4096 * 1024 * 2;
static_assert(W_END <= 35 * MiB, "weights");
constexpr size_t WS_MEMN = 35 * MiB;
constexpr size_t WS_MEMKV = 43 * MiB;
constexpr size_t WS_KROPE = 59 * MiB;
constexpr size_t WS_VFIRST = 64 * MiB;
constexpr size_t WS_XN = 128 * MiB;
constexpr size_t WS_Q = WS_XN;
constexpr size_t WS_PROJ = 256 * MiB;
constexpr size_t WS_S = 512 * MiB;
constexpr size_t WS_CQN = WS_S;
constexpr size_t WS_CKVN = WS_S + 32 * MiB;
constexpr size_t WS_ALR = WS_S + 48 * MiB;
constexpr size_t WS_PROJ2 = WS_S + 80 * MiB;
constexpr size_t WS_MIX = WS_S;
constexpr size_t WS_KN = 640 * MiB;
constexpr size_t WS_VT = 704 * MiB;
constexpr size_t WS_LOW = 768 * MiB;
constexpr size_t WS_NEED = 1024 * MiB;
constexpr size_t WS_WKT = 384 * MiB;
constexpr size_t WS_VWT = 416 * MiB;
constexpr size_t WS_P = 640 * MiB;
constexpr size_t WS_OCA = 768 * MiB;
constexpr size_t WS_HID = 256 * MiB;
constexpr size_t WS_HF32 = 768 * MiB;
constexpr size_t WS_SSP = 128 * MiB;

struct Args { const void* in[35]; float* out; unsigned char* ws; };
typedef const Args __attribute__((address_space(4)))* ArgsP;

__device__ __forceinline__ unsigned f2bf(float f) { unsigned u = __builtin_bit_cast(unsigned, f); return (u + 0x7fffu + ((u >> 16) & 1u)) >> 16; }
__device__ __forceinline__ unsigned pk2(float lo, float hi) { return f2bf(lo) | (f2bf(hi) << 16); }
__device__ __forceinline__ float bf2f(unsigned short b) { return __builtin_bit_cast(float, (unsigned)b << 16); }
__device__ __forceinline__ float bflo(unsigned w) { return __builtin_bit_cast(float, w << 16); }
__device__ __forceinline__ float bfhi(unsigned w) { return __builtin_bit_cast(float, w & 0xffff0000u); }
__device__ __forceinline__ float dppx1(float x) { return __builtin_bit_cast(float, __builtin_amdgcn_update_dpp(0, __builtin_bit_cast(int, x), 0xB1, 0xF, 0xF, true)); }
__device__ __forceinline__ float dppx2(float x) { return __builtin_bit_cast(float, __builtin_amdgcn_update_dpp(0, __builtin_bit_cast(int, x), 0x4E, 0xF, 0xF, true)); }
__device__ __forceinline__ float bperm(float x, int srclane) { return __builtin_bit_cast(float, __builtin_amdgcn_ds_bpermute(srclane << 2, __builtin_bit_cast(int, x))); }
__device__ __forceinline__ float dpp_hm_(float x) { return __builtin_bit_cast(float, __builtin_amdgcn_update_dpp(0, __builtin_bit_cast(int, x), 0x141, 0xF, 0xF, true)); }
__device__ __forceinline__ float dpp_rm_(float x) { return __builtin_bit_cast(float, __builtin_amdgcn_update_dpp(0, __builtin_bit_cast(int, x), 0x140, 0xF, 0xF, true)); }
__device__ __forceinline__ float wave_sum(float v, int lane) {
    v += dppx1(v); v += dppx2(v); v += dpp_hm_(v); v += dpp_rm_(v);
    v += bperm(v, lane ^ 16); v += bperm(v, lane ^ 32);
    return v;
}
__device__ __forceinline__ float wave_max(float v, int lane) {
    v = fmaxf(v, dppx1(v)); v = fmaxf(v, dppx2(v));
#pragma unroll
    for (int o = 4; o < 64; o <<= 1) v = fmaxf(v, bperm(v, lane ^ o));
    return v;
}
#define LDS_WAIT() asm volatile("s_waitcnt lgkmcnt(0)" ::: "memory")

struct Ctx { int tid, lane, wave, gw, ngw, bid, nblk; LAS unsigned char* lds; };


#define XB_TMO      128
#define XB_XCNT(j)  (256  + 64 * (j))
#define XB_XSUB(j)  (1280 + 64 * (j))
#define XB_XGEN(j)  (2304 + 64 * (j))
#define XB_TOP      3328
#define XB_TOPGEN   3392
#define XCD_BAR_WORDS 3456
#define XB_SPIN_CAP (1u << 23)
__device__ __forceinline__ unsigned xb_ld(unsigned* p)              { return __hip_atomic_load(p, __ATOMIC_RELAXED, __HIP_MEMORY_SCOPE_AGENT); }
__device__ __forceinline__ unsigned xb_add(unsigned* p, unsigned v) { return __hip_atomic_fetch_add(p, v, __ATOMIC_RELAXED, __HIP_MEMORY_SCOPE_AGENT); }
__device__ __forceinline__ unsigned xb_xcc_id() { return (unsigned)__builtin_amdgcn_s_getreg((3 << 11) | 20) & 0xFu; }
#define XB_SPIN(cond, bar) do { unsigned _sp = 0; while (cond) { __builtin_amdgcn_s_sleep(1); \
    if ((++_sp & 255u) == 0u) { if (xb_ld(&(bar)[XB_TMO])) break; if (_sp > XB_SPIN_CAP) { atomicAdd(&(bar)[XB_TMO], 1u); break; } } } } while (0)
__device__ __forceinline__ void xcd_barrier_post(unsigned* bar, int tid) { if (tid == 0) (void)xb_add(&bar[XB_XCNT(xb_xcc_id())], 1u); }
__device__ __forceinline__ void xcd_barrier_complete(unsigned* bar, unsigned x, unsigned G, unsigned& nloc, unsigned& nx) {
    unsigned sum, cnt, mine, sp = 0u;
    for (;;) {
        sum = 0u; cnt = 0u; mine = 0u;
#pragma unroll
        for (unsigned j = 0; j < 16; ++j) { const unsigned c = xb_ld(&bar[XB_XCNT(j)]); sum += c; cnt += (c > 0u) ? 1u : 0u; mine = (j == x) ? c : mine; }
        if (sum == G) break;
        __builtin_amdgcn_s_sleep(1);
        if ((++sp & 255u) == 0u) { if (xb_ld(&bar[XB_TMO])) break; if (sp > XB_SPIN_CAP) { atomicAdd(&bar[XB_TMO], 1u); break; } }
    }
    nloc = mine > 0u ? mine : 1u; nx = cnt > 0u ? cnt : 1u;
}
__device__ __forceinline__ void xcd_barrier(unsigned* bar, volatile LAS unsigned* st, int tid, unsigned G) {
    asm volatile("s_waitcnt vmcnt(0)" ::: "memory");
    __syncthreads();
    if (tid == 0) {
        __builtin_amdgcn_s_waitcnt(0);
        const unsigned x = xb_xcc_id();
        unsigned nloc = st[0], nx = st[1];
        if (nloc == 0u) { xcd_barrier_complete(bar, x, G, nloc, nx); st[0] = nloc; st[1] = nx; }
        const unsigned old = xb_add(&bar[XB_XSUB(x)], 1u);
        const unsigned gen = old / nloc;
        if (old + 1u == (gen + 1u) * nloc) {
            __builtin_amdgcn_fence(__ATOMIC_RELEASE, "agent");
            asm volatile("s_waitcnt vmcnt(0)" ::: "memory");
            const unsigned og = xb_add(&bar[XB_TOP], 1u);
            const unsigned tg = og / nx;
            if (og + 1u == (tg + 1u) * nx) xb_add(&bar[XB_TOPGEN], 1u);
            else XB_SPIN(xb_ld(&bar[XB_TOPGEN]) == tg, bar);
            __builtin_amdgcn_fence(__ATOMIC_ACQUIRE, "agent");
            xb_add(&bar[XB_XGEN(x)], 1u);
            asm volatile("s_waitcnt vmcnt(0)" ::: "memory");
        } else {
            XB_SPIN(xb_ld(&bar[XB_XGEN(x)]) == gen, bar);
            __builtin_amdgcn_fence(__ATOMIC_ACQUIRE, "agent");
            asm volatile("s_waitcnt vmcnt(0)" ::: "memory");
        }
    }
    __syncthreads();
}

__device__ __forceinline__ void transpose_item(const float* W, int K, int ldw, int nblk, bf16* WT, LAS float* scr, int item, int lane, const float* gain = nullptr) {
    const int kb = item / nblk, nb = item % nblk, k0 = 64 * kb, n0 = 32 * nb;
#pragma unroll
    for (int j = 0; j < 8; ++j) { const int kk = (lane >> 3) + 8 * j, nn = (lane & 7) * 4; const float gsc = gain ? gain[k0 + kk] : 1.0f;
        const f32x4 v = *(const f32x4*)(W + (size_t)(k0 + kk) * ldw + n0 + nn); LAS float* d = scr + kk * 33 + nn; d[0] = v.x * gsc; d[1] = v.y * gsc; d[2] = v.z * gsc; d[3] = v.w * gsc; }
    LDS_WAIT(); asm volatile("" ::: "memory");
    const int c = lane & 7;
#pragma unroll
    for (int j = 0; j < 4; ++j) { const int n = (lane >> 3) + 8 * j; const LAS float* s = scr + (8 * c) * 33 + n;
        u32x4 o; o.x = pk2(s[0 * 33], s[1 * 33]); o.y = pk2(s[2 * 33], s[3 * 33]); o.z = pk2(s[4 * 33], s[5 * 33]); o.w = pk2(s[6 * 33], s[7 * 33]);
        *(u32x4*)(WT + (size_t)(n0 + n) * K + k0 + 8 * c) = o; }
    LDS_WAIT(); asm volatile("" ::: "memory");
}
__device__ __forceinline__ void rms_row_to_bf16(const float* xrow, const float* gain, bf16* orow, int lane) {
    const f32x4* xr = (const f32x4*)xrow + lane; const f32x4* gr = (const f32x4*)gain + lane;
    f32x4 v[4]; float s = 0.f;
#pragma unroll
    for (int j = 0; j < 4; ++j) { v[j] = xr[64 * j]; s += (v[j].x * v[j].x + v[j].y * v[j].y) + (v[j].z * v[j].z + v[j].w * v[j].w); }
    const float rs = 1.0f / sqrtf(wave_sum(s, lane) * (1.0f / 1024.0f) + EPS);
    unsigned long long* o8 = (unsigned long long*)orow + lane;
#pragma unroll
    for (int j = 0; j < 4; ++j) { const f32x4 g = gr[64 * j]; o8[64 * j] = (unsigned long long)pk2(v[j].x * rs * g.x, v[j].y * rs * g.y) | ((unsigned long long)pk2(v[j].z * rs * g.z, v[j].w * rs * g.w) << 32); }
}

template <int PART  > __device__ __forceinline__ void convert_weights(const Ctx& c, ArgsP ap, unsigned char* ws, int l) {
    LAS float* scr = (LAS float*)(c.lds + c.wave * 16384);
    const float* w_in = l == 0 ? (const float*)ap->in[4] : (const float*)ap->in[5] + (size_t)(l - 1) * 1024 * IN1;
    const int n_in = l == 0 ? IN0 : IN1;
    const float* w_out = (const float*)ap->in[25] + (size_t)l * 1024 * 1024;
    const float* cwq = (const float*)ap->in[28] + (size_t)l * 1024 * 1024;
    const float* cwkv = (const float*)ap->in[29] + (size_t)l * 1024 * 2048;
    const float* cwo = (const float*)ap->in[30] + (size_t)l * 1024 * 1024;
    const float* wup = (const float*)ap->in[32] + (size_t)l * 1024 * 4096;
    const float* wdn = (const float*)ap->in[33] + (size_t)l * 4096 * 1024;
    const int I_IN = 16 * (n_in / 32), I_SQ = 16 * 32, I_KV = 16 * 64, I_UP = 16 * 128, I_DN = 64 * 32;
    if (PART == 0) {
        for (int it = c.gw; it < I_IN + I_SQ; it += c.ngw) {
            int r = it;
            if (r < I_IN) { transpose_item(w_in, 1024, n_in, n_in / 32, (bf16*)(ws + W_IN), scr, r, c.lane, (const float*)ap->in[3] + l * 1024); continue; } r -= I_IN;
            transpose_item(w_out, 1024, 1024, 32, (bf16*)(ws + W_OUT), scr, r, c.lane);
        }
    } else {
        for (int it = c.gw; it < 2 * I_SQ + I_KV + I_UP + I_DN; it += c.ngw) {
            int r = it;
            if (r < I_SQ) { const f32x4* s4 = (const f32x4*)(cwq + (size_t)r * 2048) + c.lane; u32x2* d2 = (u32x2*)((bf16*)(ws + W_CQ) + (size_t)r * 2048) + c.lane;
#pragma unroll
                for (int j = 0; j < 8; ++j) { const float gsc = ((const float*)ap->in[26])[l * 1024 + 2 * r + (j >> 2)]; const f32x4 v = s4[64 * j] * gsc; u32x2 o; o.x = pk2(v.x, v.y); o.y = pk2(v.z, v.w); d2[64 * j] = o; } continue; } r -= I_SQ;
            if (r < I_SQ) { transpose_item(cwo, 1024, 1024, 32, (bf16*)(ws + W_CO), scr, r, c.lane); continue; } r -= I_SQ;
            if (r < I_KV) { transpose_item(cwkv, 1024, 2048, 64, (bf16*)(ws + W_CKV), scr, r, c.lane); continue; } r -= I_KV;
            if (r < I_UP) { transpose_item(wup, 1024, 4096, 128, (bf16*)(ws + W_UP), scr, r, c.lane, (const float*)ap->in[31] + l * 1024); continue; } r -= I_UP;
            transpose_item(wdn, 4096, 1024, 32, (bf16*)(ws + W_DN), scr, r, c.lane);
        }
        return;
    }
    const int gb = c.gw * 64, ngt = c.ngw * 64;
    const float* wuq = (const float*)ap->in[9] + (size_t)l * 192 * 768;
    const float* wukv = (const float*)ap->in[11] + (size_t)l * 128 * 1024;
    const float* w2 = (const float*)ap->in[14] + (size_t)l * 32 * 512;
    const float* a2 = (const float*)ap->in[16] + (size_t)l * 32 * 512;
    const float* g2 = (const float*)ap->in[17] + (size_t)l * 96 * 512;
    const float* v2 = l > 0 ? (const float*)ap->in[19] + (size_t)(l - 1) * 32 * 512 : nullptr;
    bf16* WUQ = (bf16*)(ws + W_UQ); bf16* WKN = (bf16*)(ws + W_KN); bf16* WVT = (bf16*)(ws + W_VT); bf16* WLR = (bf16*)(ws + W_LR); bf16* WIN = (bf16*)(ws + W_IN);
    for (int eb = gb; eb < 768 * 256; eb += ngt) { const int e = eb + c.lane; const int n = e >> 8, k = e & 255; WUQ[e] = (bf16)(k < 192 ? f2bf(wuq[k * 768 + n]) : 0u); }
    for (int eb = gb; eb < 512 * 128; eb += ngt) { const int e = eb + c.lane; const int n = e >> 7, k = e & 127, h = n >> 6, d = n & 63;
        WKN[e] = (bf16)f2bf(wukv[k * 1024 + h * 128 + d]); WVT[e] = (bf16)f2bf(wukv[k * 1024 + h * 128 + 64 + d]); }
    for (int eb = gb; eb < 2048 * 128; eb += ngt) { const int e = eb + c.lane; const int n = e >> 7, k = e & 127, kind = n >> 9, cc = n & 511; float v = 0.f;
        if (kind == 0) { if (k < 32) v = w2[k * 512 + cc]; }
        else if (kind == 1) { if (k >= 32 && k < 64) v = a2[(k - 32) * 512 + cc]; }
        else if (kind == 2) { if (k < 96) v = g2[k * 512 + cc]; }
        else { if (v2 && k >= 96) v = v2[(k - 96) * 512 + cc]; }
        WLR[e] = (bf16)f2bf(v); }
    for (int eb = gb; eb < (2304 - n_in) * 1024; eb += ngt) WIN[(size_t)n_in * 1024 + eb + c.lane] = 0;
}

__device__ __forceinline__ void prep_pass(const Ctx& c, ArgsP ap, unsigned char* ws, int l) {
    const bf16* __restrict__ proj = (const bf16*)(ws + WS_PROJ); const bf16* __restrict__ proj2 = (const bf16*)(ws + WS_PROJ2);
    bf16* __restrict__ cqn = (bf16*)(ws + WS_CQN); bf16* __restrict__ ckvn = (bf16*)(ws + WS_CKVN); bf16* __restrict__ alr = (bf16*)(ws + WS_ALR); bf16* __restrict__ krope = (bf16*)(ws + WS_KROPE);
    const int* pos = (const int*)ap->in[2];
    const float* qn = (const float*)ap->in[8] + l * 192; const float* kvn = (const float*)ap->in[10] + l * 128;
    const float* mu = l == 0 ? (const float*)ap->in[6] : (const float*)ap->in[7] + (size_t)(l - 1) * 1728;
    const int lane = c.lane;
#pragma unroll 4
    for (int row = c.gw; row < MTOK; row += c.ngw) {
        const bf16* __restrict__ P = proj + (size_t)row * 2048;
        { float v[4] = {0.f, 0.f, 0.f, 0.f}; float ss = 0.f;
          if (lane < 48) { const u32x2 w = *(const u32x2*)(P + 4 * lane); v[0] = bflo(w.x); v[1] = bfhi(w.x); v[2] = bflo(w.y); v[3] = bfhi(w.y); ss = (v[0] * v[0] + v[1] * v[1]) + (v[2] * v[2] + v[3] * v[3]); }
          const float rs = 1.0f / sqrtf(wave_sum(ss, lane) * (1.0f / 192.0f) + EPS);
          u32x2 o; o.x = 0u; o.y = 0u;
          if (lane < 48) { const f32x4 g = *(const f32x4*)(qn + 4 * lane); o.x = pk2(v[0] * rs * g.x, v[1] * rs * g.y); o.y = pk2(v[2] * rs * g.z, v[3] * rs * g.w); }
          *(u32x2*)(cqn + (size_t)row * 256 + 4 * lane) = o; }
        { float v[4] = {0.f, 0.f, 0.f, 0.f}; float ss = 0.f;
          if (lane < 32) { const u32x2 w = *(const u32x2*)(P + 192 + 4 * lane); v[0] = bflo(w.x); v[1] = bfhi(w.x); v[2] = bflo(w.y); v[3] = bfhi(w.y); ss = (v[0] * v[0] + v[1] * v[1]) + (v[2] * v[2] + v[3] * v[3]); }
          const float rs = 1.0f / sqrtf(wave_sum(ss, lane) * (1.0f / 128.0f) + EPS);
          if (lane < 32) { const f32x4 g = *(const f32x4*)(kvn + 4 * lane); u32x2 o; o.x = pk2(v[0] * rs * g.x, v[1] * rs * g.y); o.y = pk2(v[2] * rs * g.z, v[3] * rs * g.w);
              *(u32x2*)(ckvn + (size_t)row * 128 + 4 * lane) = o; } }
        if (lane < 16) { const float x1 = bf2f(P[320 + lane]), x2 = bf2f(P[336 + lane]); float cs, sn; pg8::rope_cs(pos[row], lane, cs, sn);
            krope[(size_t)row * 32 + lane] = (bf16)f2bf(x1 * cs - x2 * sn); krope[(size_t)row * 32 + 16 + lane] = (bf16)f2bf(x1 * sn + x2 * cs); }
        { u32x2 o; o.x = 0u; o.y = 0u;
          const bool has_prev = (row & (SEQ - 1)) != 0;
          if (lane < 40 || (lane < 48 && l > 0)) {
              const bf16* src = lane < 40 ? P + 1888 + 4 * lane : proj2 + (size_t)row * 32 + 4 * (lane - 40);
              const bf16* psrc = lane < 40 ? P - 2048 + 1888 + 4 * lane : proj2 + (size_t)row * 32 - 32 + 4 * (lane - 40);
              const u32x2 w = *(const u32x2*)src; float cur[4] = {bflo(w.x), bfhi(w.x), bflo(w.y), bfhi(w.y)}; float prv[4] = {0.f, 0.f, 0.f, 0.f};
              if (has_prev) { const u32x2 pw = *(const u32x2*)psrc; prv[0] = bflo(pw.x); prv[1] = bfhi(pw.x); prv[2] = bflo(pw.y); prv[3] = bfhi(pw.y); }
              const f32x4 m4 = *(const f32x4*)(mu + 1536 + 4 * lane); const float mm[4] = {m4.x, m4.y, m4.z, m4.w}; float z[4];
#pragma unroll
              for (int j = 0; j < 4; ++j) { z[j] = cur[j] + (prv[j] - cur[j]) * mm[j];
                  if (lane < 8) z[j] = 1.0f - 2.0f / (__expf(2.0f * z[j]) + 1.0f); else if (lane >= 16 && lane < 40) z[j] = pg8::sigmoidf_(z[j]); }
              o.x = pk2(z[0], z[1]); o.y = pk2(z[2], z[3]); }
          *(u32x2*)(alr + (size_t)row * 256 + 4 * lane) = o; }
    }
}


#define MFMA32(a, b, c) __builtin_amdgcn_mfma_f32_32x32x16_bf16((a), (b), (c), 0, 0, 0)
constexpr int AT_KROW = 208, AT_VROW = 144;
constexpr int AT_KBYTES = 64 * AT_KROW, AT_VBYTES = 64 * AT_VROW;
constexpr int AT_BUF = AT_KBYTES + AT_VBYTES;
constexpr int AT_WSF = 2 * AT_BUF;
constexpr int AT_CTRL = AT_WSF + 8 * 256;
__device__ __forceinline__ float max3f(float a, float b, float c) { float r; asm("v_max3_f32 %0, %1, %2, %3" : "=v"(r) : "v"(a), "v"(b), "v"(c)); return r; }
__device__ __forceinline__ int crow(int r, int hi) { return (r & 3) + 8 * (r >> 2) + 4 * hi; }
__device__ __forceinline__ unsigned cvtpk(float lo, float hi) { typedef float f2 __attribute__((ext_vector_type(2))); typedef __bf16 b2 __attribute__((ext_vector_type(2))); f2 v = {lo, hi}; b2 b = __builtin_convertvector(v, b2); return __builtin_bit_cast(unsigned, b); }

__device__ __forceinline__ void mla_attn_unit(const Ctx& c, unsigned char* ws, const float* out_norm, int b, int h, int qb) {
    const int tid = c.tid, lane = c.lane, wid = c.wave, r32 = lane & 31, hi = lane >> 5;
    const bf16* Q = (const bf16*)(ws + WS_Q); const bf16* KN = (const bf16*)(ws + WS_KN); const bf16* KR = (const bf16*)(ws + WS_KROPE); const bf16* VT = (const bf16*)(ws + WS_VT);
    bf16* MIX = (bf16*)(ws + WS_MIX);
    const long rowbase = (long)b * SEQ; const int q0 = qb * 256;
    LAS unsigned char* lds = c.lds;
    LAS float* wsf = (LAS float*)(lds + AT_WSF) + wid * 64;
    bf16x8 qr[6];
    { const bf16* qp = Q + (rowbase + q0 + wid * 32 + r32) * 768 + h * 96 + hi * 8;
#pragma unroll
      for (int s = 0; s < 6; ++s) qr[s] = *(const bf16x8*)(qp + 16 * s); }
    const int nt = 4 * qb + 4;
    const int my_nt = 4 * qb + (wid >> 1) + 1;
    const int krow = tid >> 3, kch = tid & 7;
    const bf16* kn_src = KN + (rowbase + krow) * 512 + h * 64 + kch * 8;
    const bf16* vt_src = VT + ((size_t)((b * 8 + h) * 64) << 12) + krow * 64 + kch * 8;
    const int rrow = (tid & 255) >> 2, rch = tid & 3;
    const bf16* kr_src = KR + (rowbase + rrow) * 32 + rch * 8;
    const int k_dst = krow * AT_KROW + kch * 16, v_dst = AT_KBYTES + krow * AT_VROW + kch * 16, r_dst = rrow * AT_KROW + 128 + rch * 16;
    u32x4 gk, gv, gr;
#define AT_LOAD(t) do { gk = *(const u32x4*)(kn_src + (size_t)(t) * 64 * 512); gv = *(const u32x4*)(vt_src + (size_t)(t) * 4096); if (tid < 256) gr = *(const u32x4*)(kr_src + (size_t)(t) * 64 * 32); } while (0)
#define AT_STORE(bufo) do { *(LAS u32x4*)(lds + (bufo) + k_dst) = gk; *(LAS u32x4*)(lds + (bufo) + v_dst) = gv; if (tid < 256) *(LAS u32x4*)(lds + (bufo) + r_dst) = gr; } while (0)
    float m_run = 0.f, l_run = 0.f;
    f32x16 negm;
#pragma unroll
    for (int i = 0; i < 16; ++i) negm[i] = 0.f;
    f32x16 o0 = {0}, o1 = {0};
#pragma unroll
    for (int i = 0; i < 16; ++i) { o0[i] = 0.f; o1[i] = 0.f; }
    AT_LOAD(0); AT_STORE(0);
    __syncthreads();
    for (int t = 0; t < nt; ++t) {
        const int bufo = (t & 1) * AT_BUF;
        if (t + 1 < nt) AT_LOAD(t + 1);
        if (t < my_nt) {
            const LAS unsigned char* kb = lds + bufo + r32 * AT_KROW + hi * 16;
            f32x16 p0, p1;
            { const bf16x8 a0 = *(const LAS bf16x8*)(kb); const bf16x8 a1 = *(const LAS bf16x8*)(kb + 32 * AT_KROW);
              p0 = MFMA32(a0, qr[0], negm); p1 = MFMA32(a1, qr[0], negm); }
#pragma unroll
            for (int s = 1; s < 6; ++s) {
                const bf16x8 a0 = *(const LAS bf16x8*)(kb + s * 32);
                const bf16x8 a1 = *(const LAS bf16x8*)(kb + 32 * AT_KROW + s * 32);
                p0 = MFMA32(a0, qr[s], p0); p1 = MFMA32(a1, qr[s], p1);
            }
            asm volatile("s_nop 15\n\ts_nop 7" : "+v"(p0), "+v"(p1));
            float mx;
            { float xa = max3f(p0[0], p0[1], p1[0]), xb = max3f(p0[2], p0[3], p1[1]); xa = max3f(xa, p1[2], p1[3]);
#pragma unroll
              for (int r = 4; r < 16; r += 4) { xa = max3f(xa, p0[r], p0[r + 1]); xb = max3f(xb, p0[r + 2], p0[r + 3]); xa = max3f(xa, p1[r], p1[r + 1]); xb = max3f(xb, p1[r + 2], p1[r + 3]); }
              mx = fmaxf(xa, xb); }
            mx = fmaxf(mx, bperm(mx, lane ^ 32));
            const bool first = (t == 0);
            if (first || __builtin_amdgcn_ballot_w64(mx > 0.f) != 0ull) {
                const float dl = first ? mx : fmaxf(mx, 0.f);
                const float alpha = __builtin_amdgcn_exp2f(-dl);
                m_run += dl; l_run *= alpha;
#pragma unroll
                for (int i = 0; i < 16; ++i) { p0[i] -= dl; p1[i] -= dl; negm[i] = -m_run; }
                if (hi == 0) wsf[r32] = alpha;
                LDS_WAIT();
#pragma unroll
                for (int i = 0; i < 16; ++i) { const float f = wsf[crow(i, hi)]; o0[i] *= f; o1[i] *= f; }
            }
            float ps = 0.f;
#pragma unroll
            for (int i = 0; i < 16; ++i) { p0[i] = __builtin_amdgcn_exp2f(p0[i]); p1[i] = __builtin_amdgcn_exp2f(p1[i]); ps += p0[i] + p1[i]; }
            l_run += ps;
            const LAS unsigned char* vb = lds + bufo + AT_KBYTES + r32 * AT_VROW + hi * 8;
#pragma unroll
            for (int half = 0; half < 2; ++half) {
#pragma unroll
                for (int s = 0; s < 2; ++s) {
                    u32x4 pw;
                    if (half == 0) { pw.x = cvtpk(p0[8 * s], p0[8 * s + 1]); pw.y = cvtpk(p0[8 * s + 2], p0[8 * s + 3]); pw.z = cvtpk(p0[8 * s + 4], p0[8 * s + 5]); pw.w = cvtpk(p0[8 * s + 6], p0[8 * s + 7]); }
                    else { pw.x = cvtpk(p1[8 * s], p1[8 * s + 1]); pw.y = cvtpk(p1[8 * s + 2], p1[8 * s + 3]); pw.z = cvtpk(p1[8 * s + 4], p1[8 * s + 5]); pw.w = cvtpk(p1[8 * s + 6], p1[8 * s + 7]); }
                    const bf16x8 pa = __builtin_bit_cast(bf16x8, pw);
                    const int ko = (half * 32 + s * 16) * 2;
                    const s16x4 lo0 = *(const LAS s16x4*)(vb + ko), hi0 = *(const LAS s16x4*)(vb + ko + 16);
                    const s16x4 lo1 = *(const LAS s16x4*)(vb + 32 * AT_VROW + ko), hi1 = *(const LAS s16x4*)(vb + 32 * AT_VROW + ko + 16);
                    const bf16x8 v0 = __builtin_shufflevector(lo0, hi0, 0, 1, 2, 3, 4, 5, 6, 7);
                    const bf16x8 v1 = __builtin_shufflevector(lo1, hi1, 0, 1, 2, 3, 4, 5, 6, 7);
                    o0 = MFMA32(pa, v0, o0); o1 = MFMA32(pa, v1, o1);
                }
            }
        }
        if (t + 1 < nt) AT_STORE(((t + 1) & 1) * AT_BUF);
        __syncthreads();
    }
#undef AT_LOAD
#undef AT_STORE
    l_run += bperm(l_run, lane ^ 32);
    if (hi == 0) wsf[r32] = l_run;
    LDS_WAIT();
    const float g0 = out_norm[h * 64 + r32], g1 = out_norm[h * 64 + 32 + r32];
#pragma unroll
    for (int i = 0; i < 16; ++i) {
        const float il = 1.0f / wsf[crow(i, hi)];
        const float a = o0[i] * il, bb = o1[i] * il;
        float ss = a * a + bb * bb;
        ss += dppx1(ss); ss += dppx2(ss); ss += bperm(ss, lane ^ 4); ss += bperm(ss, lane ^ 8); ss += bperm(ss, lane ^ 16);
        const float rs = 1.0f / sqrtf(ss * (1.0f / 64.0f) + EPS);
        bf16* op = MIX + (rowbase + q0 + wid * 32 + crow(i, hi)) * 1024 + h * 64 + r32;
        op[0] = (bf16)f2bf(a * rs * g0); op[32] = (bf16)f2bf(bb * rs * g1);
    }
    LDS_WAIT();
    __syncthreads();
}

typedef float f32x2 __attribute__((ext_vector_type(2)));
constexpr int SC_T = 32, SC_NCH = SEQ / SC_T;
constexpr int SC_ARR = SC_T * 64 * 4;
constexpr int SC_KK = 0, SC_W = SC_ARR, SC_B = 2 * SC_ARR, SC_K = 3 * SC_ARR, SC_WR = 4 * SC_ARR, SC_V = 5 * SC_ARR, SC_Y = 6 * SC_ARR, SC_SC = 7 * SC_ARR  , SC_BON = SC_SC + SC_T * 8  , SC_BUF = SC_BON + SC_T * 4 + 128;
static_assert(2 * SC_BUF <= 131072, "scan LDS");
__device__ __forceinline__ float dpp_hm(float x) { return __builtin_bit_cast(float, __builtin_amdgcn_update_dpp(0, __builtin_bit_cast(int, x), 0x141, 0xF, 0xF, true)); }
__device__ __forceinline__ float dpp_rm(float x) { return __builtin_bit_cast(float, __builtin_amdgcn_update_dpp(0, __builtin_bit_cast(int, x), 0x140, 0xF, 0xF, true)); }
__device__ __forceinline__ float red8(float v) { v += dppx1(v); v += dppx2(v); v += dpp_hm(v); return v; }
__device__ __forceinline__ float red16(float v) { v += dppx1(v); v += dppx2(v); v += dpp_hm(v); v += dpp_rm(v); return v; }
__device__ __forceinline__ f32x4 unpk4(u32x2 w) { f32x4 r; r.x = bflo(w.x); r.y = bfhi(w.x); r.z = bflo(w.y); r.w = bfhi(w.y); return r; }
__device__ __forceinline__ float hsum4(f32x4 v) { return (v.x + v.y) + (v.z + v.w); }

struct ScanP { const bf16* proj; const bf16* low; bf16* vfirst; bf16* mix; const float* mu; const float* k_k; const float* k_a; const float* r_k; const float* ln_w; const float* ln_b; int layer; };
struct ScanRaw { u32x2 r, k, v, rp, kp, vp, e, a, vg, vf; };
struct ScanC { f32x4 mu_r, mu_k, mu_v, kk_c, ka_c, rk_c, lnw, lnb; };

__device__ __forceinline__ ScanRaw scan_load_raw(const ScanP& p, int chunk, int t, int b, int colb) {
    ScanRaw x; const int s = chunk * SC_T + t; const size_t row = (size_t)b * SEQ + s;
    const bf16* pr = p.proj + row * 2048 + MLA_COLS + colb;
    x.r = *(const u32x2*)pr; x.k = *(const u32x2*)(pr + 512); x.v = *(const u32x2*)(pr + 1024);
    const u32x2 z = {0u, 0u};
    x.rp = z; x.kp = z; x.vp = z;
    if (s > 0) { x.rp = *(const u32x2*)(pr - 2048); x.kp = *(const u32x2*)(pr + 512 - 2048); x.vp = *(const u32x2*)(pr + 1024 - 2048); }
    const bf16* lw = p.low + row * 2048 + colb;
    x.e = *(const u32x2*)lw; x.a = *(const u32x2*)(lw + 512);
    x.vg = z; x.vf = z;
    if (p.layer > 0) { x.vg = *(const u32x2*)(lw + 1536); x.vf = *(const u32x2*)(p.vfirst + row * 512 + colb); }
    return x;
}
__device__ __forceinline__ void scan_stage_write(const ScanP& p, const ScanRaw& x, const ScanC& k, LAS unsigned char* lds, int bufo, int chunk, int t, int b, int colb, int cg) {
    const f32x4 rc = unpk4(x.r), kc = unpk4(x.k), vc = unpk4(x.v), rpv = unpk4(x.rp), kpv = unpk4(x.kp), vpv = unpk4(x.vp);
    const f32x4 r = rc + (rpv - rc) * k.mu_r, kx = kc + (kpv - kc) * k.mu_k; f32x4 v = vc + (vpv - vc) * k.mu_v;
    const f32x4 e = unpk4(x.e), a = unpk4(x.a);
    f32x4 w; w.x = __builtin_amdgcn_exp2f(e.x); w.y = __builtin_amdgcn_exp2f(e.y); w.z = __builtin_amdgcn_exp2f(e.z); w.w = __builtin_amdgcn_exp2f(e.w);
    const int s = chunk * SC_T + t; const size_t row = (size_t)b * SEQ + s;
    if (p.layer == 0) { u32x2 o; o.x = cvtpk(v.x, v.y); o.y = cvtpk(v.z, v.w); *(u32x2*)(p.vfirst + row * 512 + colb) = o; }
    else { const f32x4 vg = unpk4(x.vg), vf = unpk4(x.vf); v = v + (vf - v) * vg; }
    f32x4 kk = kx * k.kk_c; const float n2 = red16(hsum4(kk * kk)); kk = kk * __builtin_amdgcn_rsqf(fmaxf(n2, 1e-24f));
    const f32x4 kmod = kx * (1.0f + (a - 1.0f) * k.ka_c);
    const f32x4 bv = kk * a, wr = w * r;
    const float br = red16(hsum4(bv * r)), kr = red16(hsum4(kmod * r)), bonus = red16(hsum4(r * kmod * k.rk_c));
    LAS unsigned char* base = lds + bufo + t * 256 + cg * 16;
    *(LAS f32x4*)(base + SC_KK) = kk; *(LAS f32x4*)(base + SC_W) = w; *(LAS f32x4*)(base + SC_B) = bv; *(LAS f32x4*)(base + SC_K) = kmod; *(LAS f32x4*)(base + SC_WR) = wr; *(LAS f32x4*)(base + SC_V) = v;
    if (cg == 0) { f32x2 sc; sc.x = br; sc.y = kr; *(LAS f32x2*)(lds + bufo + SC_SC + t * 8) = sc; *(LAS float*)(lds + bufo + SC_BON + t * 4) = bonus; }
}
struct ScanPost { f32x4 y, v; float bonus; };
__device__ __forceinline__ ScanPost scan_post_read(LAS unsigned char* lds, int bufo, int t, int cg) {
    ScanPost q; const LAS unsigned char* base = lds + bufo + t * 256 + cg * 16;
    q.y = *(const LAS f32x4*)(base + SC_Y); q.v = *(const LAS f32x4*)(base + SC_V); q.bonus = *(const LAS float*)(lds + bufo + SC_BON + t * 4); return q;
}
__device__ __forceinline__ void scan_post_finish(const ScanP& p, const ScanPost& q, u32x2 graw, const ScanC& k, int chunk, int t, int b, int colb) {
    const int s = chunk * SC_T + t; const size_t row = (size_t)b * SEQ + s;
    const float mean = red16(hsum4(q.y)) * (1.0f / 64.0f); const f32x4 d = q.y - mean; const float var = red16(hsum4(d * d)) * (1.0f / 64.0f);
    const float rs = __builtin_amdgcn_rsqf(var + GN_EPS);
    const f32x4 g = unpk4(graw);
    const f32x4 yn = (d * rs * k.lnw + k.lnb + q.v * q.bonus) * g;
    u32x2 o; o.x = cvtpk(yn.x, yn.y); o.y = cvtpk(yn.z, yn.w);
    *(u32x2*)(p.mix + row * 1024 + 512 + colb) = o;
}

struct StepIn { f32x4 kk[4], w[4], b[4], k[4], wr[4]; float vv; f32x2 sc; };
__device__ __forceinline__ StepIn scan_ld_step(const LAS unsigned char* bb, int t, int kq, int row) {
    StepIn x; const LAS unsigned char* p = bb + t * 256 + kq * 64;
#pragma unroll
    for (int i = 0; i < 4; ++i) x.kk[i] = *(const LAS f32x4*)(p + SC_KK + 16 * i);
#pragma unroll
    for (int i = 0; i < 4; ++i) x.wr[i] = *(const LAS f32x4*)(p + SC_WR + 16 * i);
#pragma unroll
    for (int i = 0; i < 4; ++i) x.k[i] = *(const LAS f32x4*)(p + SC_K + 16 * i);
#pragma unroll
    for (int i = 0; i < 4; ++i) x.b[i] = *(const LAS f32x4*)(p + SC_B + 16 * i);
#pragma unroll
    for (int i = 0; i < 4; ++i) x.w[i] = *(const LAS f32x4*)(p + SC_W + 16 * i);
    x.vv = *(const LAS float*)(bb + SC_V + t * 256 + row * 4);
    x.sc = *(const LAS f32x2*)(bb + SC_SC + t * 8);
    return x;
}
#define PKFMA(a, b, c) __builtin_elementwise_fma((a), (b), (c))
#define LO2(v) ((f32x2){(v).x, (v).y})
#define HI2(v) ((f32x2){(v).z, (v).w})
__device__ __forceinline__ void scan_do_step(f32x2 (&S)[8], const StepIn& x, LAS unsigned char* bb, int t, int kq, int row) {
    f32x2 sa2 = S[0] * LO2(x.kk[0]), sb2 = S[1] * HI2(x.kk[0]);
    f32x2 ya2 = S[0] * LO2(x.wr[0]), yb2 = S[1] * HI2(x.wr[0]);
#pragma unroll
    for (int i = 1; i < 4; ++i) { sa2 = PKFMA(S[2 * i], LO2(x.kk[i]), sa2); sb2 = PKFMA(S[2 * i + 1], HI2(x.kk[i]), sb2); ya2 = PKFMA(S[2 * i], LO2(x.wr[i]), ya2); yb2 = PKFMA(S[2 * i + 1], HI2(x.wr[i]), yb2); }
    sa2 = sa2 + sb2; ya2 = ya2 + yb2;
    float sa = sa2.x + sa2.y, yv = ya2.x + ya2.y;
    sa += dppx1(sa); yv += dppx1(yv); sa += dppx2(sa); yv += dppx2(yv);
    sa = -sa;
    const float yo = yv + sa * x.sc.x + x.vv * x.sc.y;
    const f32x2 sav = {sa, sa}, vvv = {x.vv, x.vv};
#pragma unroll
    for (int i = 0; i < 4; ++i) {
        f32x2 t0 = vvv * LO2(x.k[i]), t1 = vvv * HI2(x.k[i]);
        t0 = PKFMA(sav, LO2(x.b[i]), t0); t1 = PKFMA(sav, HI2(x.b[i]), t1);
        S[2 * i] = PKFMA(S[2 * i], LO2(x.w[i]), t0); S[2 * i + 1] = PKFMA(S[2 * i + 1], HI2(x.w[i]), t1);
    }
    if (kq == 0) *(LAS float*)(bb + SC_Y + t * 256 + row * 4) = yo;
}

__device__ __forceinline__ void scan_unit(const Ctx& c, const ScanP& p, int b, int h) {
    LAS unsigned char* lds = c.lds; const int lane = c.lane, wid = c.wave;
    if (wid >= 4) {
        const int sw = wid - 4, tq = lane >> 4, cg = lane & 15, colb = h * 64 + 4 * cg;
        ScanC k; k.mu_r = *(const f32x4*)(p.mu + colb); k.mu_k = *(const f32x4*)(p.mu + 512 + colb); k.mu_v = *(const f32x4*)(p.mu + 1024 + colb);
        k.kk_c = *(const f32x4*)(p.k_k + colb); k.ka_c = *(const f32x4*)(p.k_a + colb); k.rk_c = *(const f32x4*)(p.r_k + colb); k.lnw = *(const f32x4*)(p.ln_w + colb); k.lnb = *(const f32x4*)(p.ln_b + colb);
        const int t0 = 8 * sw + tq, t1 = t0 + 4;
        { const ScanRaw a0 = scan_load_raw(p, 0, t0, b, colb), a1 = scan_load_raw(p, 0, t1, b, colb);
          scan_stage_write(p, a0, k, lds, 0, 0, t0, b, colb, cg); scan_stage_write(p, a1, k, lds, 0, 0, t1, b, colb, cg); }
        ScanRaw c0 = scan_load_raw(p, 1, t0, b, colb), c1 = scan_load_raw(p, 1, t1, b, colb);
        for (int ch = 0; ch < SC_NCH; ++ch) {
            __syncthreads();
            ScanRaw n0 = c0, n1 = c1;
            if (ch + 2 < SC_NCH) { n0 = scan_load_raw(p, ch + 2, t0, b, colb); n1 = scan_load_raw(p, ch + 2, t1, b, colb); }
            u32x2 g0 = {0u, 0u}, g1 = {0u, 0u}; ScanPost q0, q1;
            if (ch >= 1) {
                const size_t rowp = (size_t)b * SEQ + (ch - 1) * SC_T;
                g0 = *(const u32x2*)(p.low + (rowp + t0) * 2048 + 1024 + colb); g1 = *(const u32x2*)(p.low + (rowp + t1) * 2048 + 1024 + colb);
                q0 = scan_post_read(lds, ((ch - 1) & 1) * SC_BUF, t0, cg); q1 = scan_post_read(lds, ((ch - 1) & 1) * SC_BUF, t1, cg);
            }
            if (ch + 1 < SC_NCH) { scan_stage_write(p, c0, k, lds, ((ch + 1) & 1) * SC_BUF, ch + 1, t0, b, colb, cg); scan_stage_write(p, c1, k, lds, ((ch + 1) & 1) * SC_BUF, ch + 1, t1, b, colb, cg); }
            if (ch >= 1) { scan_post_finish(p, q0, g0, k, ch - 1, t0, b, colb); scan_post_finish(p, q1, g1, k, ch - 1, t1, b, colb); }
            c0 = n0; c1 = n1;
        }
        __syncthreads();
        { const size_t rowp = (size_t)b * SEQ + (SC_NCH - 1) * SC_T; const int bo = ((SC_NCH - 1) & 1) * SC_BUF;
          const u32x2 g0 = *(const u32x2*)(p.low + (rowp + t0) * 2048 + 1024 + colb), g1 = *(const u32x2*)(p.low + (rowp + t1) * 2048 + 1024 + colb);
          const ScanPost q0 = scan_post_read(lds, bo, t0, cg), q1 = scan_post_read(lds, bo, t1, cg);
          scan_post_finish(p, q0, g0, k, SC_NCH - 1, t0, b, colb); scan_post_finish(p, q1, g1, k, SC_NCH - 1, t1, b, colb); }
    } else {
        const int kq = lane & 3, r0 = wid * 16 + (lane >> 2);
        f32x2 S[8];
#pragma unroll
        for (int i = 0; i < 8; ++i) { S[i].x = 0.f; S[i].y = 0.f; }
        for (int ch = 0; ch < SC_NCH; ++ch) {
            __syncthreads();
            LAS unsigned char* bb = lds + (ch & 1) * SC_BUF;
            StepIn A = scan_ld_step(bb, 0, kq, r0), B;
#pragma unroll
            for (int t = 0; t < SC_T; t += 2) {
                B = scan_ld_step(bb, t + 1, kq, r0);
                scan_do_step(S, A, bb, t, kq, r0);
                if (t + 2 < SC_T) A = scan_ld_step(bb, t + 2, kq, r0);
                scan_do_step(S, B, bb, t + 1, kq, r0);
            }
        }
        __syncthreads();
    }
    __syncthreads();
}

#define GEMM_PHASE_ROT_A(EpiT, g, e, rot, ALIGN) do { NEWCTX(); pg8::StaticOrder S_; S_.init((g).M, (g).N, c.nblk, (c.bid + c.nblk - (rot)) % c.nblk); pg8::gemm_phase<EpiT, pg8::StaticOrder, ALIGN, true>(c.lds, (g), S_, (e), c.tid); } while (0)
#define GEMM_PHASE_ROT(EpiT, g, e, rot) GEMM_PHASE_ROT_A(EpiT, g, e, rot, true)
#define GEMM_PHASE(EpiT, g, e) GEMM_PHASE_ROT(EpiT, g, e, 0)

typedef pg8::EpiResidual<true, false> EPI_T0; typedef pg8::EpiResidual<false, false> EPI_T1;
__global__ void __launch_bounds__(NTHREADS, 2) fwd_megakernel(Args a_unused) {
    extern __shared__ __attribute__((aligned(16))) unsigned char lds_raw[];
    cg::grid_group grid = cg::this_grid();
    Ctx c;
    const int wave_s = __builtin_amdgcn_readfirstlane((int)threadIdx.x >> 6);
    ArgsP ap; unsigned char* ws; float* hout; const float* xin; bf16* XN; unsigned* ctl;
#define NEWCTX() do { int l_; asm volatile("v_mbcnt_lo_u32_b32 %0, -1, 0\n\tv_mbcnt_hi_u32_b32 %0, -1, %0" : "=v"(l_)); \
        ap = (ArgsP)__builtin_amdgcn_kernarg_segment_ptr(); asm volatile("" : "+s"(ap)); \
        { int b_ = blockIdx.x, n_ = gridDim.x, w_ = wave_s; asm volatile("" : "+s"(b_), "+s"(n_), "+s"(w_)); c.bid = b_; c.nblk = n_; c.wave = w_; } \
        c.lane = l_; c.tid = c.wave * 64 + l_; c.gw = c.bid * NWAVES + c.wave; c.ngw = c.nblk * NWAVES; c.lds = (LAS unsigned char*)lds_raw; \
        ws = ap->ws; hout = ap->out; xin = (const float*)ap->in[0]; XN = (bf16*)hout;     ctl = (unsigned*)(ws + WS_CTL); } while (0)
    NEWCTX();
    volatile LAS unsigned* bar_st = (volatile LAS unsigned*)(lds_raw + 131072 + 64);
    if (c.tid < 2) bar_st[c.tid] = 0u;
    __syncthreads();
    xcd_barrier_post((unsigned*)(ws + WS_CTL + CTL_BAR), c.tid);
#define SYNC() do { NEWCTX(); xcd_barrier((unsigned*)(ws + WS_CTL + CTL_BAR), bar_st, c.tid, (unsigned)c.nblk); NEWCTX(); } while (0)
#define SS(i) ((float*)(ws + WS_SSP))

    { const float* mem = (const float*)ap->in[1]; const float* mg = (const float*)ap->in[27]; bf16* memn = (bf16*)(ws + WS_MEMN);
      for (int row = c.gw; row < MMEM; row += c.ngw) rms_row_to_bf16(mem + (size_t)row * 1024, mg, memn + (size_t)row * 1024, c.lane); }
    { float* __restrict__ ss0 = SS(0);
#pragma unroll 4
      for (int row = c.gw; row < MTOK; row += c.ngw) {
          const f32x4* __restrict__ xr = (const f32x4*)(xin + (size_t)row * 1024) + c.lane; unsigned long long* __restrict__ o8 = (unsigned long long*)(XN + (size_t)row * 1024) + c.lane;
          float s = 0.f;
#pragma unroll
          for (int j = 0; j < 4; ++j) { const f32x4 v = xr[64 * j]; s += (v.x * v.x + v.y * v.y) + (v.z * v.z + v.w * v.w);
              o8[64 * j] = (unsigned long long)pk2(v.x, v.y) | ((unsigned long long)pk2(v.z, v.w) << 32); }
          s = wave_sum(s, c.lane);
          if (c.lane < 16) ss0[(size_t)row * 16 + c.lane] = c.lane == 0 ? s : 0.f;
      } }
    convert_weights<0>(c, ap, ws, 0);
    grid.sync(); NEWCTX();

    for (int l = 0; l < DEPTH; ++l) {
        { pg8::Gemm g = pg8::mk_gemm(XN, (const bf16*)(ws + W_IN), MTOK, l == 0 ? 2048 : 2304, 1024);
          pg8::EpiBf16<0> e = pg8::mk_epi_bf16((bf16*)(ws + WS_PROJ), 2048, 1.0f); e.c2_lo = 2048; e.c2_hi = 2080; e.O2 = (bf16*)(ws + WS_PROJ2); e.ldc2 = 32; e.ss = SS(3 * l);
          GEMM_PHASE(pg8::EpiBf16<0>, g, e); }
        SYNC();
        prep_pass(c, ap, ws, l);
        convert_weights<1>(c, ap, ws, l);
        SYNC();
        { pg8::Gemm g = pg8::mk_gemm((const bf16*)(ws + WS_CQN), (const bf16*)(ws + W_UQ), MTOK, 768, 256);
          pg8::EpiQRope e; e.O = (bf16*)(ws + WS_Q); e.pos = (const int*)ap->in[2]; e.scale = MLA_QSCALE; GEMM_PHASE(pg8::EpiQRope, g, e); }
        { pg8::Gemm g = pg8::mk_gemm((const bf16*)(ws + WS_CKVN), (const bf16*)(ws + W_KN), MTOK, 512, 128);
          pg8::EpiBf16<0> e = pg8::mk_epi_bf16((bf16*)(ws + WS_KN), 512, 1.0f); GEMM_PHASE(pg8::EpiBf16<0>, g, e); }
        { pg8::Gemm g = pg8::mk_gemm((const bf16*)(ws + W_VT), (const bf16*)(ws + WS_CKVN), 512, MTOK, 128);
          pg8::EpiVT e; e.O = (bf16*)(ws + WS_VT); GEMM_PHASE(pg8::EpiVT, g, e); }
        { pg8::Gemm g = pg8::mk_gemm((const bf16*)(ws + WS_ALR), (const bf16*)(ws + W_LR), MTOK, l == 0 ? 1536 : 2048, 128); g.lda = 256; g.a_lo = (long)512 * 256; g.a_sh = 2; g.a_pn2 = 128;
          pg8::EpiLowrank e; e.O = (bf16*)(ws + WS_LOW); e.w0 = (const float*)ap->in[13] + l * 512; e.a0 = (const float*)ap->in[15] + l * 512; e.v0 = l > 0 ? (const float*)ap->in[18] + (l - 1) * 512 : (const float*)ap->in[15];
          GEMM_PHASE(pg8::EpiLowrank, g, e); }
        { pg8::Gemm g = pg8::mk_gemm((const bf16*)(ws + WS_MEMN), (const bf16*)(ws + W_CKV), MMEM, 2048, 1024);
          pg8::EpiBf16<0> e = pg8::mk_epi_bf16((bf16*)(ws + WS_MEMKV), 2048, 1.0f); GEMM_PHASE_ROT(pg8::EpiBf16<0>, g, e, 128); }
        SYNC();
        if (c.bid < 128) {
            ScanP p; p.proj = (const bf16*)(ws + WS_PROJ); p.low = (const bf16*)(ws + WS_LOW); p.vfirst = (bf16*)(ws + WS_VFIRST); p.mix = (bf16*)(ws + WS_MIX);
            p.mu = l == 0 ? (const float*)ap->in[6] : (const float*)ap->in[7] + (size_t)(l - 1) * 1728;
            p.k_k = (const float*)ap->in[20] + l * 512; p.k_a = (const float*)ap->in[21] + l * 512; p.r_k = (const float*)ap->in[22] + l * 512;
            p.ln_w = (const float*)ap->in[23] + l * 512; p.ln_b = (const float*)ap->in[24] + l * 512; p.layer = l;
            scan_unit(c, p, c.bid >> 3, c.bid & 7);
        }
        { const float* onorm = (const float*)ap->in[12] + l * 512; LAS unsigned* uw = (LAS unsigned*)(c.lds + AT_CTRL);
          for (;;) {
              if (c.tid == 0) *uw = atomicAdd(ctl + 64 * l, 1u);
              __syncthreads();
              const unsigned u = *uw;
              __syncthreads();
              if (u >= 2048u) break;
              const int qb = 15 - (int)(u >> 7), bh = (int)(u & 127);
              mla_attn_unit(c, ws, onorm, bh >> 3, bh & 7, qb);
          } }
        SYNC();
        { pg8::Gemm g = pg8::mk_gemm((const bf16*)(ws + WS_MIX), (const bf16*)(ws + W_OUT), MTOK, 1024, 1024);
          if (l == 0) { pg8::EpiResidual<true, false> e; e.basef = xin; e.baseh = XN; e.outf = nullptr; e.outh = XN; e.ss = SS(1); GEMM_PHASE(EPI_T0, g, e); }
          else { pg8::EpiResidual<false, false> e; e.basef = nullptr; e.baseh = XN; e.outf = nullptr; e.outh = XN; e.ss = SS(3 * l + 1); GEMM_PHASE(EPI_T1, g, e); } }
        { pg8::Gemm g = pg8::mk_gemm((const bf16*)(ws + WS_MEMKV), (const bf16*)(ws + W_CQ), 64 * 256, 1024, 256); g.lda = 2048; g.ldb = 1024;
          g.a_d = 4; g.a_hi = (long)256 * 2048 * 2; g.a_lo = 512; g.b_pn = (long)256 * 1024 * 2; g.b_pmod = 4; g.b_pmo = 512;
          pg8::EpiBf16<0> e = pg8::mk_epi_bf16((bf16*)(ws + WS_WKT), 1024, 1.0f); GEMM_PHASE(pg8::EpiBf16<0>, g, e); }
        { pg8::Gemm g = pg8::mk_gemm((const bf16*)(ws + W_CO), (const bf16*)(ws + WS_MEMKV) + 1024, 64 * 256, 1024, 256); g.lda = 1024; g.ldb = 2048;
          g.a_d = 4; g.a_hi = 0; g.a_lo = (long)256 * 1024 * 2; g.a_pn = 512; g.b_pn = 512; g.tpb = 4; g.b_bt = (long)256 * 2048 * 2;
          pg8::EpiBf16<0> e = pg8::mk_epi_bf16((bf16*)(ws + WS_VWT), 1024, 1.0f); GEMM_PHASE(pg8::EpiBf16<0>, g, e); }
        SYNC();
        { pg8::Gemm g = pg8::mk_gemm(XN, (const bf16*)(ws + WS_WKT), MTOK, 1024, 1024); g.tpb = 16; g.b_bt = (long)1024 * 1024 * 2;
          pg8::EpiSoftmax e; e.P = (bf16*)(ws + WS_P); e.xm = (LAS float*)(c.lds + 131072 + 1024); e.xs = (LAS float*)(c.lds + 131072 + 1024 + 4096); e.ss = SS(3 * l + 1); e.scale = CA_QSCALE;
          GEMM_PHASE(pg8::EpiSoftmax, g, e); }
        SYNC();
        { pg8::Gemm g = pg8::mk_gemm((const bf16*)(ws + WS_P), (const bf16*)(ws + WS_VWT), MTOK, 1024, 1024); g.tpb = 16; g.b_bt = (long)1024 * 1024 * 2;
          pg8::EpiResidual<false, false> e; e.basef = nullptr; e.baseh = XN; e.outf = nullptr; e.outh = XN; e.ss = SS(3 * l + 2); GEMM_PHASE(EPI_T1, g, e); }
        SYNC();
        if (l + 1 < DEPTH) convert_weights<0>(c, ap, ws, l + 1);
        LDS_WAIT(); __syncthreads();
        { pg8::Gemm g = pg8::mk_gemm(XN, (const bf16*)(ws + W_UP), MTOK, DFF, 1024);
          pg8::EpiBf16<1> e; e.O = (bf16*)(ws + WS_HID); e.ldc = DFF; e.scale = 1.0f; e.c2_lo = 1 << 30; e.c2_hi = 1 << 30; e.O2 = e.O; e.ldc2 = 0; e.ss = SS(3 * l + 2); GEMM_PHASE(pg8::EpiBf16<1>, g, e); }
        SYNC();
        { pg8::Gemm g = pg8::mk_gemm((const bf16*)(ws + WS_HID), (const bf16*)(ws + W_DN), MTOK, 1024, DFF);
          pg8::EpiResidual<false, false> e; e.basef = nullptr; e.baseh = XN; e.outf = nullptr; e.outh = l + 1 < DEPTH ? XN : (bf16*)(ws + WS_HF32); e.ss = SS(3 * l + 3); GEMM_PHASE(EPI_T1, g, e); }
        SYNC();
    }
    { const float* g = (const float*)ap->in[34]; const float* ssf = SS(3 * DEPTH); const bf16* hf = (const bf16*)(ws + WS_HF32);
#pragma unroll 4
      for (int row = c.gw; row < MTOK; row += c.ngw) {
          const u32x2* __restrict__ xr = (const u32x2*)(hf + (size_t)row * 1024) + c.lane; f32x4* __restrict__ orow = (f32x4*)(hout + (size_t)row * 1024) + c.lane; const f32x4* __restrict__ gr = (const f32x4*)g + c.lane;
          float sp = c.lane < 16 ? ssf[(size_t)row * 16 + c.lane] : 0.f; sp = wave_sum(sp, c.lane);
          const float rs = 1.0f / sqrtf(sp * (1.0f / 1024.0f) + EPS);
#pragma unroll
          for (int j = 0; j < 4; ++j) { const u32x2 w = xr[64 * j]; f32x4 v; v.x = bflo(w.x); v.y = bfhi(w.x); v.z = bflo(w.y); v.w = bfhi(w.y); orow[64 * j] = v * rs * gr[64 * j]; }
      } }
}

extern "C" void kernel_launch(void* const* d_in, const int* in_sizes, int n_in, void* d_out, int out_size, void* d_ws, size_t ws_size, hipStream_t stream) {
    static int grid = 0;
    if (grid == 0) {
        if (n_in != 35 || out_size != MTOK * DM || ws_size < WS_NEED) { fprintf(stderr, "kernel_launch: unexpected shapes (n_in %d out %d ws %zu)\n", n_in, out_size, ws_size); grid = -1; return; }
        int dev = 0, cus = 0, per_cu = 0;
        hipGetDevice(&dev); hipDeviceGetAttribute(&cus, hipDeviceAttributeMultiprocessorCount, dev);
        hipFuncSetAttribute((const void*)fwd_megakernel, hipFuncAttributeMaxDynamicSharedMemorySize, LDS_BYTES);
        hipOccupancyMaxActiveBlocksPerMultiprocessor(&per_cu, (const void*)fwd_megakernel, NTHREADS, LDS_BYTES);
        (void)hipGetLastError();
        if (per_cu < 1) per_cu = 1;
        grid = cus * 1;
        if (grid < 128) { fprintf(stderr, "kernel_launch: grid %d too small\n", grid); grid = -1; return; }
    }
    if (grid < 0) return;
    hipMemsetAsync((char*)d_ws + WS_CTL, 0, CTL_BYTES, stream);
    Args a{};
    for (int i = 0; i < 35; ++i) a.in[i] = d_in[i];
    a.out = (float*)d_out; a.ws = (unsigned char*)d_ws;
    void* params[] = {&a};
    hipError_t e = hipLaunchCooperativeKernel((const void*)fwd_megakernel, dim3(grid), dim3(NTHREADS), params, LDS_BYTES, stream);
    if (e != hipSuccess) fprintf(stderr, "cooperative launch failed: %s (grid %d)\n", hipGetErrorString(e), grid);
}
```

```cpp
#include <hip/hip_runtime.h>
#include <hip/hip_cooperative_groups.h>
#include <cstdint>
#include <cstdio>
namespace cg = cooperative_groups;
namespace pg8 {
#define PG8_LAS __attribute__((address_space(3)))
typedef unsigned short bf16_t;
typedef short bf16x8 __attribute__((ext_vector_type(8)));
typedef float f32x4 __attribute__((ext_vector_type(4)));
typedef unsigned u32x4 __attribute__((ext_vector_type(4)));
constexpr int BM = 256, BK = 64, HALF = 128, HTB = HALF * BK * 2  , STAGE_BYTES = 8 * HTB, NXCD = 8, WGM = 8;

__host__ __device__ __forceinline__ int lds_byte(int r, int c) { const int st = (r >> 4) * 2 + (c >> 5), rr = r & 15, cc = c & 31, ob = rr * 64 + cc * 2; return st * 1024 + (ob ^ (((ob >> 9) & 1) << 5)); }
__host__ __device__ __forceinline__ void stage_rc(int b, int& R, int& C) { const int st = b / 1024, sb = b % 1024, swz = sb ^ (((sb >> 9) & 1) << 5); R = (st >> 1) * 16 + swz / 64; C = (st & 1) * 32 + (swz % 64) / 2; }
__host__ __device__ __forceinline__ int perm32(int rho) { const int n = rho >> 4, i = rho & 15; return 8 * (i >> 2) + 4 * n + (i & 3); }

struct Unit { int pm, pn; };

struct StaticOrder {
    int nM, nN, nwg, G, c;
    __host__ __device__ void init(int M, int N, int G_, int c_) { nM = M / BM; nN = N / BM; nwg = nM * nN; G = G_; c = c_; }
    __host__ __device__ bool next(int i, Unit& u) const {
        const long L = (long)i * G + c; if (L >= nwg) return false;
        int wgid = (int)L; { const int q = nwg / NXCD, r = nwg % NXCD, xcd = wgid % NXCD, off = wgid / NXCD; wgid = (xcd < r ? xcd * (q + 1) : r * (q + 1) + (xcd - r) * q) + off; }
        const int nig = WGM * nN, gid = wgid / nig, fm = gid * WGM, gsz = (nM - fm) < WGM ? (nM - fm) : WGM;
        u.pm = fm + ((wgid % nig) % gsz); u.pn = (wgid % nig) / gsz; return true;
    }
    __device__ __forceinline__ void a_ready(const Unit&) const {}
    __device__ __forceinline__ void done(const Unit&) const {}
};

struct Gemm { const bf16_t* A; const bf16_t* Bt; int M, N, K, lda, ldb; long a_hi, a_lo, a_pn, a_pn2, b_pn, b_bt, b_pmo; int a_d, a_sh, tpb, b_pmod;
    __device__ __forceinline__ const char* uA(const Unit& u) const { return (const char*)A + (size_t)(u.pm / a_d) * a_hi + (size_t)(u.pm % a_d) * a_lo + (size_t)u.pn * a_pn + (size_t)(u.pn >> a_sh) * a_pn2; }
    __device__ __forceinline__ const char* uB(const Unit& u) const { return (const char*)Bt + (size_t)u.pn * b_pn + (size_t)(u.pm / tpb) * b_bt + (size_t)(u.pm % b_pmod) * b_pmo; } };
__device__ __forceinline__ Gemm mk_gemm(const bf16_t* A, const bf16_t* Bt, int M, int N, int K) { Gemm g; g.A = A; g.Bt = Bt; g.M = M; g.N = N; g.K = K; g.lda = K; g.ldb = K; g.a_hi = 0; g.a_lo = (long)512 * K; g.a_d = 1 << 30; g.a_pn = 0; g.a_pn2 = 0; g.a_sh = 0;
    g.b_pn = (long)512 * K; g.b_bt = 0; g.tpb = 1 << 30; g.b_pmo = 0; g.b_pmod = 1; return g; }

__device__ __forceinline__ unsigned cvt_pk_bf16(float lo, float hi) { unsigned r; asm volatile("v_cvt_pk_bf16_f32 %0, %1, %2" : "=v"(r) : "v"(lo), "v"(hi)); return r; }
typedef float f32x2 __attribute__((ext_vector_type(2)));
typedef unsigned u32x2 __attribute__((ext_vector_type(2)));

__constant__ float ROPE_INV[16] = {1.000000000e+00f, 5.623413252e-01f, 3.162277660e-01f, 1.778279410e-01f, 1.000000000e-01f, 5.623413252e-02f, 3.162277660e-02f, 1.778279410e-02f,
                                   1.000000000e-02f, 5.623413252e-03f, 3.162277660e-03f, 1.778279410e-03f, 1.000000000e-03f, 5.623413252e-04f, 3.162277660e-04f, 1.778279410e-04f};
__device__ __forceinline__ void rope_cs(int pos, int i, float& c, float& s) {
    double t = (double)pos * (double)ROPE_INV[i] * 0.15915494309189535;
    t -= __builtin_rint(t);
    const float tf = (float)t;
    c = __builtin_amdgcn_cosf(tf); s = __builtin_amdgcn_sinf(tf);
}
__device__ __forceinline__ float sigmoidf_(float x) { return 1.0f / (1.0f + __expf(-x)); }

template <int ACT> struct EpiBf16 {
    static constexpr bool PERM = true, AFTER_DRAIN = false;
    bf16_t* O; long ldc; float scale; int c2_lo, c2_hi; bf16_t* O2; long ldc2; int nt;     const float* ss;
    __device__ __forceinline__ void operator()(const f32x4 (&acc)[2][2][4][2], const Unit& u, int wr, int wc, int fr, int fq) const {
        const int row0 = u.pm * BM + wr * 64 + fr; const int col0 = u.pn * BM + wc * 32 + 8 * fq;
#pragma unroll
        for (int ai = 0; ai < 2; ++ai)
#pragma unroll
            for (int m = 0; m < 4; ++m) { const long row = row0 + ai * HALF + m * 16; float rsc = scale; if (ss) { const f32x4* pp = (const f32x4*)(ss + row * 16); const f32x4 a0 = pp[0], a1 = pp[1], a2 = pp[2], a3 = pp[3]; const f32x4 t = (a0 + a1) + (a2 + a3); rsc = scale * (1.0f / sqrtf(((t[0] + t[1]) + (t[2] + t[3])) * (1.0f / 1024.0f) + 1e-6f)); }
#pragma unroll
                for (int bj = 0; bj < 2; ++bj) { f32x4 v0 = acc[ai][bj][m][0] * rsc, v1 = acc[ai][bj][m][1] * rsc; const int col = col0 + bj * HALF;
                    if (ACT == 1) {
#pragma unroll
                        for (int j = 0; j < 4; ++j) { float a = fmaxf(v0[j], 0.f), b = fmaxf(v1[j], 0.f); v0[j] = a * a; v1[j] = b * b; } }
                    u32x4 w; w.x = cvt_pk_bf16(v0[0], v0[1]); w.y = cvt_pk_bf16(v0[2], v0[3]); w.z = cvt_pk_bf16(v1[0], v1[1]); w.w = cvt_pk_bf16(v1[2], v1[3]);
                    if (col < c2_lo) { if (ACT == 1) { const bf16_t* sp_ = O + row * ldc + col; asm volatile("global_store_dwordx4 %0, %1, off nt" :: "v"(sp_), "v"(w) : "memory"); } else *(u32x4*)(O + row * ldc + col) = w; }
                    else if (col < c2_hi) *(u32x4*)(O2 + row * ldc2 + (col - c2_lo)) = w; } }
    }
};
__device__ __forceinline__ EpiBf16<0> mk_epi_bf16(bf16_t* O, long ldc, float scale) { EpiBf16<0> e; e.O = O; e.ldc = ldc; e.scale = scale; e.c2_lo = 1 << 30; e.c2_hi = 1 << 30; e.O2 = O; e.ldc2 = 0; e.nt = 0; e.ss = nullptr; return e; }


struct EpiVT {
    static constexpr bool PERM = true, AFTER_DRAIN = false;
    bf16_t* O;
    __device__ __forceinline__ void operator()(const f32x4 (&acc)[2][2][4][2], const Unit& u, int wr, int wc, int fr, int fq) const {
        const int row0 = u.pm * BM + wr * 64 + fr; const int col0 = u.pn * BM + wc * 32 + 8 * fq;
#pragma unroll
        for (int ai = 0; ai < 2; ++ai)
#pragma unroll
            for (int m = 0; m < 4; ++m) { const int f = row0 + ai * HALF + m * 16;
#pragma unroll
                for (int bj = 0; bj < 2; ++bj) { const f32x4 v0 = acc[ai][bj][m][0], v1 = acc[ai][bj][m][1]; const int tok = col0 + bj * HALF;
                    u32x4 w; w.x = cvt_pk_bf16(v0[0], v0[1]); w.y = cvt_pk_bf16(v0[2], v0[3]); w.z = cvt_pk_bf16(v1[0], v1[1]); w.w = cvt_pk_bf16(v1[2], v1[3]);
                    const size_t idx = ((size_t)(((tok >> 12) * 8 + (f >> 6)) * 64 + ((tok & 4095) >> 6)) << 12) + (size_t)((f & 63) * 64 + (tok & 63));
                    *(u32x4*)(O + idx) = w; } }
    }
};

struct EpiQRope {
    static constexpr bool PERM = false, AFTER_DRAIN = false;
    bf16_t* O; const int* pos; float scale;
    __device__ __forceinline__ void operator()(const f32x4 (&acc)[2][2][4][2], const Unit& u, int wr, int wc, int fr, int fq) const {
#pragma unroll
        for (int bj = 0; bj < 2; ++bj) { const int cbase = u.pn * BM + bj * HALF + wc * 32; const bool is_rope = ((cbase >> 5) % 3) == 2;
#pragma unroll
            for (int ai = 0; ai < 2; ++ai)
#pragma unroll
                for (int m = 0; m < 4; ++m) { const long row = u.pm * BM + ai * HALF + wr * 64 + m * 16 + fr; f32x4 v0 = acc[ai][bj][m][0], v1 = acc[ai][bj][m][1];
                    if (is_rope) { const int p = pos[row];
#pragma unroll
                        for (int j = 0; j < 4; ++j) { float c, s; rope_cs(p, 4 * fq + j, c, s); const float a = v0[j], b = v1[j]; v0[j] = a * c - b * s; v1[j] = a * s + b * c; } }
                    v0 = v0 * scale; v1 = v1 * scale;
                    u32x2 w0, w1; w0.x = cvt_pk_bf16(v0[0], v0[1]); w0.y = cvt_pk_bf16(v0[2], v0[3]); w1.x = cvt_pk_bf16(v1[0], v1[1]); w1.y = cvt_pk_bf16(v1[2], v1[3]);
                    bf16_t* p0 = O + row * 768 + cbase + 4 * fq; *(u32x2*)p0 = w0; *(u32x2*)(p0 + 16) = w1; } }
    }
};

struct EpiLowrank {
    static constexpr bool PERM = true, AFTER_DRAIN = false;
    bf16_t* O; const float* w0; const float* a0; const float* v0;
    __device__ __forceinline__ void operator()(const f32x4 (&acc)[2][2][4][2], const Unit& u, int wr, int wc, int fr, int fq) const {
        asm volatile("" : "+v"(fr), "+v"(fq));
        const int row0 = u.pm * BM + wr * 64 + fr; const int col0 = u.pn * BM + wc * 32 + 8 * fq; const int kind = u.pn >> 1;
#pragma unroll
        for (int bj = 0; bj < 2; ++bj) { const int col = col0 + bj * HALF; const int c5 = col & 511;
            float bias[8];
#pragma unroll
            for (int j = 0; j < 8; ++j) bias[j] = kind == 0 ? w0[c5 + j] : kind == 1 ? a0[c5 + j] : kind == 3 ? v0[c5 + j] : 0.f;
#pragma unroll
            for (int ai = 0; ai < 2; ++ai)
#pragma unroll
                for (int m = 0; m < 4; ++m) { const long row = row0 + ai * HALF + m * 16; float v[8];
#pragma unroll
                    for (int j = 0; j < 4; ++j) { v[j] = acc[ai][bj][m][0][j] + bias[j]; v[4 + j] = acc[ai][bj][m][1][j] + bias[4 + j]; }
#pragma unroll
                    for (int j = 0; j < 8; ++j) {
                        if (kind == 0) { v[j] = -0.87503877f * __builtin_amdgcn_rcpf(1.0f + __expf(-v[j])); }
                        else if (kind == 1 || kind == 3) v[j] = sigmoidf_(v[j]);
                    }
                    u32x4 w; w.x = cvt_pk_bf16(v[0], v[1]); w.y = cvt_pk_bf16(v[2], v[3]); w.z = cvt_pk_bf16(v[4], v[5]); w.w = cvt_pk_bf16(v[6], v[7]);
                    *(u32x4*)(O + row * 2048 + col) = w; } }
    }
};

template <bool BASE_F32, bool OUT_F32> struct EpiResidual {
    static constexpr bool PERM = false, AFTER_DRAIN = false;
    const float* basef; const bf16_t* baseh; float* outf; bf16_t* outh; float* ss;
    __device__ __forceinline__ void operator()(const f32x4 (&acc)[2][2][4][2], const Unit& u, int wr, int wc, int fr, int fq) const {
        asm volatile("" : "+v"(fr), "+v"(fq));
        const int lane = fq * 16 + fr; const int colb = u.pn * BM + wc * 32 + 4 * fq;
#pragma unroll
        for (int ai = 0; ai < 2; ++ai)
#pragma unroll
            for (int m = 0; m < 4; ++m) { const int row = u.pm * BM + ai * HALF + wr * 64 + m * 16 + fr; const size_t off = (size_t)row * 1024 + colb; float s = 0.f;
#pragma unroll
                for (int bj = 0; bj < 2; ++bj)
#pragma unroll
                    for (int n = 0; n < 2; ++n) { const size_t o = off + bj * HALF + n * 16; f32x4 b;
                        if (BASE_F32) b = *(const f32x4*)(basef + o);
                        else { const u32x2 w = *(const u32x2*)(baseh + o); b[0] = __builtin_bit_cast(float, w.x << 16); b[1] = __builtin_bit_cast(float, w.x & 0xffff0000u); b[2] = __builtin_bit_cast(float, w.y << 16); b[3] = __builtin_bit_cast(float, w.y & 0xffff0000u); }
                        const f32x4 v = b + acc[ai][bj][m][n];
                        s += (v[0] * v[0] + v[1] * v[1]) + (v[2] * v[2] + v[3] * v[3]);
                        if (OUT_F32) *(f32x4*)(outf + o) = v;
                        else { u32x2 w; w.x = cvt_pk_bf16(v[0], v[1]); w.y = cvt_pk_bf16(v[2], v[3]); *(u32x2*)(outh + o) = w; } }
                s += __builtin_bit_cast(float, __builtin_amdgcn_ds_bpermute((lane ^ 16) << 2, __builtin_bit_cast(int, s)));
                s += __builtin_bit_cast(float, __builtin_amdgcn_ds_bpermute((lane ^ 32) << 2, __builtin_bit_cast(int, s)));
                if (fq == 0) ss[(size_t)row * 16 + u.pn * 4 + wc] = s; }
    }
};

struct EpiSoftmax {
    static constexpr bool PERM = true, AFTER_DRAIN = false;
    bf16_t* P; PG8_LAS float* xm; PG8_LAS float* xs; const float* ss; float scale;
    __device__ __forceinline__ void operator()(const f32x4 (&acc_c)[2][2][4][2], const Unit& u, int wr, int wc, int fr, int fq) const {
        f32x4 (&acc)[2][2][4][2] = const_cast<f32x4 (&)[2][2][4][2]>(acc_c);
        asm volatile("" : "+v"(fr), "+v"(fq));
        const int lane = fq * 16 + fr;
#pragma unroll
        for (int ai = 0; ai < 2; ++ai)
#pragma unroll
            for (int m = 0; m < 4; ++m) { float mx = -INFINITY;
                const f32x4* pp = (const f32x4*)(ss + ((size_t)u.pm * BM + ai * HALF + wr * 64 + m * 16 + fr) * 16); const f32x4 t4 = (pp[0] + pp[1]) + (pp[2] + pp[3]);
                const float rsc = scale * (1.0f / sqrtf(((t4[0] + t4[1]) + (t4[2] + t4[3])) * (1.0f / 1024.0f) + 1e-6f));
#pragma unroll
                for (int bj = 0; bj < 2; ++bj)
#pragma unroll
                    for (int n = 0; n < 2; ++n) { const f32x4 v = acc[ai][bj][m][n] * rsc; acc[ai][bj][m][n] = v; mx = fmaxf(mx, fmaxf(fmaxf(v[0], v[1]), fmaxf(v[2], v[3]))); }
                mx = fmaxf(mx, __builtin_bit_cast(float, __builtin_amdgcn_ds_bpermute((lane ^ 16) << 2, __builtin_bit_cast(int, mx))));
                mx = fmaxf(mx, __builtin_bit_cast(float, __builtin_amdgcn_ds_bpermute((lane ^ 32) << 2, __builtin_bit_cast(int, mx))));
                if (fq == 0) xm[(ai * HALF + wr * 64 + m * 16 + fr) * 4 + wc] = mx; }
        asm volatile("s_waitcnt lgkmcnt(0)" ::: "memory"); __builtin_amdgcn_s_barrier(); asm volatile("" ::: "memory");
#pragma unroll
        for (int ai = 0; ai < 2; ++ai)
#pragma unroll
            for (int m = 0; m < 4; ++m) { const int r = ai * HALF + wr * 64 + m * 16 + fr; const f32x4 q = *(const PG8_LAS f32x4*)(xm + r * 4);
                const float M = fmaxf(fmaxf(q[0], q[1]), fmaxf(q[2], q[3])); float s = 0.f;
#pragma unroll
                for (int bj = 0; bj < 2; ++bj)
#pragma unroll
                    for (int n = 0; n < 2; ++n) { f32x4 v = acc[ai][bj][m][n];
#pragma unroll
                        for (int j = 0; j < 4; ++j) v[j] = __builtin_amdgcn_exp2f(v[j] - M);
                        s += (v[0] + v[1]) + (v[2] + v[3]); acc[ai][bj][m][n] = v; }
                s += __builtin_bit_cast(float, __builtin_amdgcn_ds_bpermute((lane ^ 16) << 2, __builtin_bit_cast(int, s)));
                s += __builtin_bit_cast(float, __builtin_amdgcn_ds_bpermute((lane ^ 32) << 2, __builtin_bit_cast(int, s)));
                if (fq == 0) xs[r * 4 + wc] = s; }
        asm volatile("s_waitcnt lgkmcnt(0)" ::: "memory"); __builtin_amdgcn_s_barrier(); asm volatile("" ::: "memory");
        const int col0 = u.pn * BM + wc * 32 + 8 * fq;
#pragma unroll
        for (int ai = 0; ai < 2; ++ai)
#pragma unroll
            for (int m = 0; m < 4; ++m) { const int r = ai * HALF + wr * 64 + m * 16 + fr; const f32x4 q = *(const PG8_LAS f32x4*)(xs + r * 4);
                const float inv = 1.0f / ((q[0] + q[1]) + (q[2] + q[3])); const size_t row = (size_t)u.pm * BM + r;
#pragma unroll
                for (int bj = 0; bj < 2; ++bj) { const f32x4 v0 = acc[ai][bj][m][0] * inv, v1 = acc[ai][bj][m][1] * inv;
                    u32x4 w; w.x = cvt_pk_bf16(v0[0], v0[1]); w.y = cvt_pk_bf16(v0[2], v0[3]); w.z = cvt_pk_bf16(v1[0], v1[1]); w.w = cvt_pk_bf16(v1[2], v1[3]);
                    *(u32x4*)(P + row * 1024 + col0 + bj * HALF) = w; } }
        asm volatile("s_waitcnt lgkmcnt(0)" ::: "memory");
    }
};

struct EpiF32 {
    static constexpr bool PERM = false, AFTER_DRAIN = false;
    float* out; long ldc;
    __device__ __forceinline__ void operator()(const f32x4 (&acc)[2][2][4][2], const Unit& u, int wr, int wc, int fr, int fq) const {
#pragma unroll
        for (int ai = 0; ai < 2; ++ai)
#pragma unroll
            for (int m = 0; m < 4; ++m) { const size_t off = (size_t)(u.pm * BM + ai * HALF + wr * 64 + m * 16 + fr) * ldc + u.pn * BM + wc * 32 + 4 * fq;
#pragma unroll
                for (int bj = 0; bj < 2; ++bj)
#pragma unroll
                    for (int n = 0; n < 2; ++n) *(f32x4*)(out + off + bj * HALF + n * 16) = acc[ai][bj][m][n]; }
    }
};

template <class Epi, class Sched, bool ALIGN_EPI = false, bool SP2 = false>
__device__ __forceinline__ void gemm_phase(PG8_LAS unsigned char* lds, const Gemm g, const Sched& S, const Epi& E, int tid_in) {
    int tid_l = tid_in; asm volatile("" : "+v"(tid_l));
    const int tid = tid_l, wid = __builtin_amdgcn_readfirstlane(tid >> 6), lane = tid & 63, wr = wid >> 2, wc = wid & 3, fr = lane & 15, fq = lane >> 4;
    const int K = g.K, nt = K / BK;
    unsigned voffA[2], voffB[2];
#pragma unroll
    for (int i = 0; i < 2; ++i) { int R, C; stage_rc(tid * 16 + i * 8192, R, C); const int Rb = Epi::PERM ? ((R & ~31) + perm32(R & 31)) : R;
        voffA[i] = (unsigned)(R * g.lda + C) * 2u; voffB[i] = (unsigned)(Rb * g.ldb + C) * 2u; }
    const size_t kstep = (size_t)(BK * 2);
    const size_t hstepA = (size_t)HALF * g.lda * 2, hstepB = (size_t)HALF * g.ldb * 2;

    const unsigned ldsw = (unsigned)wid * 1024u;
    const int aoff = lds_byte(wr * 64 + fr, fq * 8), boff = lds_byte(wc * 32 + fr, fq * 8);
#define PG8_SA(b, h) (((b) * 2 + (h)) * HTB)
#define PG8_SB(b, h) ((4 + (b) * 2 + (h)) * HTB)
#define PG8_STAGE(bufoff, gbase, voff) do { _Pragma("unroll") for (int _i = 0; _i < 2; ++_i) \
        __builtin_amdgcn_global_load_lds((const unsigned*)((const char*)(gbase) + (voff)[_i]), (PG8_LAS unsigned*)(lds + (bufoff) + ldsw + _i * 8192), 16, 0, 0); } while (0)
#define PG8_LDA(dst, b, h) do { _Pragma("unroll") for (int m = 0; m < 4; ++m) _Pragma("unroll") for (int k = 0; k < 2; ++k) dst[m][k] = *(const PG8_LAS bf16x8*)(lds + PG8_SA(b, h) + aoff + m * 2048 + k * 1024); } while (0)
#define PG8_LDB(dst, b, h) do { _Pragma("unroll") for (int n = 0; n < 2; ++n) _Pragma("unroll") for (int k = 0; k < 2; ++k) dst[n][k] = *(const PG8_LAS bf16x8*)(lds + PG8_SB(b, h) + boff + n * 2048 + k * 1024); } while (0)
#define PG8_MMA(ai, bj, At, Bt) do { __builtin_amdgcn_s_setprio(1); _Pragma("unroll") for (int m = 0; m < 4; ++m) _Pragma("unroll") for (int n = 0; n < 2; ++n) _Pragma("unroll") for (int k = 0; k < 2; ++k) \
        acc[ai][bj][m][n] = __builtin_amdgcn_mfma_f32_16x16x32_bf16(Bt[n][k], At[m][k], acc[ai][bj][m][n], 0, 0, 0); __builtin_amdgcn_s_setprio(0); } while (0)
#define PG8_WAIT_V(n) asm volatile("s_waitcnt vmcnt(" #n ")" ::: "memory")
#define PG8_WAIT_L(n) asm volatile("s_waitcnt lgkmcnt(" #n ")" ::: "memory")
#define PG8_BAR __builtin_amdgcn_s_barrier()
#define PG8_SCHED __builtin_amdgcn_sched_barrier(0)
    Unit cur, nxt; int ui = 0;
    if (!S.next(0, cur)) return;
    f32x4 acc[2][2][4][2];
#pragma unroll
    for (int a = 0; a < 2; ++a)
#pragma unroll
        for (int b = 0; b < 2; ++b)
#pragma unroll
            for (int m = 0; m < 4; ++m)
#pragma unroll
                for (int n = 0; n < 2; ++n) acc[a][b][m][n] = (f32x4){0.f, 0.f, 0.f, 0.f};
    bf16x8 At[4][2], B0[2][2], B1[2][2];
    const char* cA = g.uA(cur); const char* cB = g.uB(cur);
    S.a_ready(cur);
    if constexpr (SP2) {
        PG8_STAGE(PG8_SB(0, 0), cB, voffB); PG8_STAGE(PG8_SB(0, 1), cB + hstepB, voffB); PG8_STAGE(PG8_SA(0, 0), cA, voffA); PG8_STAGE(PG8_SA(0, 1), cA + hstepA, voffA);
        if (wr == 1) PG8_BAR;
        PG8_WAIT_V(2); PG8_BAR;
        PG8_STAGE(PG8_SB(1, 0), cB + kstep, voffB); PG8_STAGE(PG8_SA(1, 0), cA + kstep, voffA); PG8_STAGE(PG8_SB(1, 1), cB + hstepB + kstep, voffB);
        PG8_WAIT_V(6); PG8_BAR;
    } else {
        PG8_STAGE(PG8_SB(0, 0), cB, voffB); PG8_STAGE(PG8_SA(0, 0), cA, voffA); PG8_STAGE(PG8_SB(0, 1), cB + hstepB, voffB); PG8_STAGE(PG8_SA(0, 1), cA + hstepA, voffA);
        if (wr == 1) PG8_BAR;
        PG8_WAIT_V(4); PG8_BAR;
        PG8_STAGE(PG8_SB(1, 0), cB + kstep, voffB); PG8_STAGE(PG8_SA(1, 0), cA + kstep, voffA); PG8_STAGE(PG8_SB(1, 1), cB + hstepB + kstep, voffB);
        PG8_WAIT_V(6); PG8_BAR;
    }
    for (;;) {
        const bool has_next = S.next(ui + 1, nxt);
        const char* nA = has_next ? g.uA(nxt) : cA; const char* nB = has_next ? g.uB(nxt) : cB;
        for (int t = 0; t < nt; t += 2) {
            const bool last = (t == nt - 2);
            const char* a1 = cA + (size_t)(t + 1) * kstep;
            const char* a2 = last ? nA : cA + (size_t)(t + 2) * kstep; const char* b2 = last ? nB : cB + (size_t)(t + 2) * kstep;
            const char* a3 = a2 + kstep; const char* b3 = b2 + kstep;
            if (last && has_next) S.a_ready(nxt);
            if constexpr (SP2) {
            PG8_LDB(B0, 0, 0); PG8_LDB(B1, 0, 1); PG8_SCHED; PG8_LDA(At, 0, 0); PG8_STAGE(PG8_SA(1, 1), a1 + hstepA, voffA);
            PG8_WAIT_V(8); PG8_WAIT_L(0); PG8_BAR; PG8_MMA(0, 0, At, B0); PG8_MMA(0, 1, At, B1); PG8_BAR; PG8_SCHED;
            PG8_LDA(At, 0, 1); PG8_STAGE(PG8_SB(0, 0), b2, voffB); PG8_STAGE(PG8_SB(0, 1), b2 + hstepB, voffB); PG8_STAGE(PG8_SA(0, 0), a2, voffA);
            PG8_WAIT_V(8); PG8_WAIT_L(0); PG8_BAR; PG8_MMA(1, 0, At, B0); PG8_MMA(1, 1, At, B1); PG8_BAR; PG8_SCHED;
            PG8_LDB(B0, 1, 0); PG8_LDB(B1, 1, 1); PG8_SCHED; PG8_LDA(At, 1, 0); PG8_STAGE(PG8_SA(0, 1), a2 + hstepA, voffA);
            PG8_WAIT_V(8); PG8_WAIT_L(0); PG8_BAR; PG8_MMA(0, 0, At, B0); PG8_MMA(0, 1, At, B1); PG8_BAR; PG8_SCHED;
            PG8_LDA(At, 1, 1); PG8_STAGE(PG8_SB(1, 0), b3, voffB); PG8_STAGE(PG8_SB(1, 1), b3 + hstepB, voffB); PG8_STAGE(PG8_SA(1, 0), a3, voffA);
            PG8_WAIT_V(8); PG8_WAIT_L(0); PG8_BAR; PG8_MMA(1, 0, At, B0); PG8_MMA(1, 1, At, B1); PG8_BAR; PG8_SCHED;
            } else {
            PG8_LDB(B0, 0, 0); PG8_SCHED; PG8_LDA(At, 0, 0); PG8_STAGE(PG8_SA(1, 1), a1 + hstepA, voffA);
            PG8_WAIT_L(8); PG8_BAR; PG8_WAIT_L(0); PG8_MMA(0, 0, At, B0); PG8_BAR; PG8_SCHED;
            PG8_LDB(B1, 0, 1); PG8_STAGE(PG8_SB(0, 0), b2, voffB);
            PG8_BAR; PG8_WAIT_L(0); PG8_MMA(0, 1, At, B1); PG8_BAR;
            PG8_LDA(At, 0, 1); PG8_STAGE(PG8_SA(0, 0), a2, voffA);
            PG8_BAR; PG8_WAIT_L(0); PG8_MMA(1, 0, At, B0); PG8_BAR; PG8_SCHED;
            PG8_STAGE(PG8_SB(0, 1), b2 + hstepB, voffB);
            PG8_WAIT_V(6); PG8_BAR; PG8_MMA(1, 1, At, B1); PG8_BAR;
            PG8_LDB(B0, 1, 0); PG8_SCHED; PG8_LDA(At, 1, 0); PG8_STAGE(PG8_SA(0, 1), a2 + hstepA, voffA);
            PG8_WAIT_L(8); PG8_BAR; PG8_WAIT_L(0); PG8_MMA(0, 0, At, B0); PG8_BAR; PG8_SCHED;
            PG8_LDB(B1, 1, 1); PG8_STAGE(PG8_SB(1, 0), b3, voffB);
            PG8_BAR; PG8_WAIT_L(0); PG8_MMA(0, 1, At, B1); PG8_BAR;
            PG8_LDA(At, 1, 1); PG8_STAGE(PG8_SA(1, 0), a3, voffA);
            PG8_BAR; PG8_WAIT_L(0); PG8_MMA(1, 0, At, B0); PG8_BAR; PG8_SCHED;
            PG8_STAGE(PG8_SB(1, 1), b3 + hstepB, voffB);
            PG8_WAIT_V(6); PG8_BAR; PG8_MMA(1, 1, At, B1); PG8_BAR;
            }
        }
        if constexpr (ALIGN_EPI) { if (wr == 0) PG8_BAR; }
        if constexpr (!Epi::AFTER_DRAIN) { E(acc, cur, wr, wc, fr, fq); S.done(cur); }
        if (!has_next) break;
#pragma unroll
        for (int a = 0; a < 2; ++a)
#pragma unroll
            for (int b = 0; b < 2; ++b)
#pragma unroll
                for (int m = 0; m < 4; ++m)
#pragma unroll
                    for (int n = 0; n < 2; ++n) acc[a][b][m][n] = (f32x4){0.f, 0.f, 0.f, 0.f};
        cur = nxt; cA = nA; cB = nB; ++ui;
        if constexpr (ALIGN_EPI) { if (wr == 1) PG8_BAR; }
    }
    PG8_WAIT_V(0);
    if constexpr (!ALIGN_EPI) { if (wr == 0) PG8_BAR; }
    PG8_BAR;
    if constexpr (Epi::AFTER_DRAIN) { E.fused(acc, cur, wr, wc, fr, fq, lds, wid, lane); S.done(cur); }
#undef PG8_SA
#undef PG8_SB
#undef PG8_STAGE
#undef PG8_LDA
#undef PG8_LDB
#undef PG8_MMA
#undef PG8_WAIT_V
#undef PG8_WAIT_L
#undef PG8_BAR
#undef PG8_SCHED
}
}

#define LAS __attribute__((address_space(3)))
typedef unsigned short bf16;
typedef float f32x4 __attribute__((ext_vector_type(4)));
typedef float f32x16 __attribute__((ext_vector_type(16)));
typedef short bf16x8 __attribute__((ext_vector_type(8)));
typedef short s16x4 __attribute__((ext_vector_type(4)));
typedef unsigned u32x4 __attribute__((ext_vector_type(4)));
typedef unsigned u32x2 __attribute__((ext_vector_type(2)));

constexpr int NB = 16, SEQ = 4096, DM = 1024, DEPTH = 4, MEMLEN = 256;
constexpr int MTOK = NB * SEQ;
constexpr int MMEM = NB * MEMLEN;
constexpr int MLA_COLS = 352, RW = 512;
constexpr int IN0 = 2048, IN1 = 2080;
constexpr int DFF = 4096;
constexpr float EPS = 1e-6f, GN_EPS = 64e-5f;
constexpr float LOG2E = 1.4426950408889634f;
constexpr float MLA_QSCALE = 0.14724444602590306f;
constexpr float CA_QSCALE = 0.09016844005556021f;
constexpr int NTHREADS = 512, NWAVES = 8;
constexpr int LDS_BYTES = 147456;

constexpr size_t MiB = 1u << 20;
constexpr size_t WS_CTL = 0, CTL_BYTES = 1 * MiB;
constexpr size_t CTL_BAR = 4096, CTL_SS = 65536;
static_assert(CTL_SS + 3 * (size_t)MTOK * 4 <= CTL_BYTES, "ctl");
constexpr size_t WS_W = 1 * MiB;
constexpr size_t W_IN = WS_W;
constexpr size_t W_UQ = W_IN + (size_t)2304 * 1024 * 2;
constexpr size_t W_KN = W_UQ + (size_t)768 * 256 * 2;
constexpr size_t W_VT = W_KN + (size_t)512 * 128 * 2;
constexpr size_t W_LR = W_VT + (size_t)512 * 128 * 2;
constexpr size_t W_OUT = W_LR + (size_t)2048 * 256 * 2;
constexpr size_t W_CQ = W_OUT + (size_t)1024 * 1024 * 2;
constexpr size_t W_CKV = W_CQ + (size_t)1024 * 1024 * 2;
constexpr size_t W_CO = W_CKV + (size_t)2048 * 1024 * 2;
constexpr size_t W_UP = W_CO + (size_t)1024 * 1024 * 2;
constexpr size_t W_DN = W_UP + (size_t)4096 * 1024 * 2;
constexpr size_t W_END = W_DN + (size_t)4096 * 1024 * 2;
static_assert(W_END <= 35 * MiB, "weights");
constexpr size_t WS_MEMN = 35 * MiB;
constexpr size_t WS_MEMKV = 43 * MiB;
constexpr size_t WS_KROPE = 59 * MiB;
constexpr size_t WS_VFIRST = 64 * MiB;
constexpr size_t WS_XN = 128 * MiB;
constexpr size_t WS_Q = WS_XN;
constexpr size_t WS_PROJ = 256 * MiB;
constexpr size_t WS_S = 512 * MiB;
constexpr size_t WS_CQN = WS_S;
constexpr size_t WS_CKVN = WS_S + 32 * MiB;
constexpr size_t WS_ALR = WS_S + 48 * MiB;
constexpr size_t WS_PROJ2 = WS_S + 80 * MiB;
constexpr size_t WS_MIX = WS_S;
constexpr size_t WS_KN = 640 * MiB;
constexpr size_t WS_VT = 704 * MiB;
constexpr size_t WS_LOW = 768 * MiB;
constexpr size_t WS_NEED = 1024 * MiB;
constexpr size_t WS_WKT = 384 * MiB;
constexpr size_t WS_VWT = 416 * MiB;
constexpr size_t WS_P = 640 * MiB;
constexpr size_t WS_OCA = 768 * MiB;
constexpr size_t WS_HID = 256 * MiB;
constexpr size_t WS_HF32 = 768 * MiB;
constexpr size_t WS_SSP = 128 * MiB;

struct Args { const void* in[35]; float* out; unsigned char* ws; };
typedef const Args __attribute__((address_space(4)))* ArgsP;

__device__ __forceinline__ unsigned f2bf(float f) { unsigned u = __builtin_bit_cast(unsigned, f); return (u + 0x7fffu + ((u >> 16) & 1u)) >> 16; }
__device__ __forceinline__ unsigned pk2(float lo, float hi) { return f2bf(lo) | (f2bf(hi) << 16); }
__device__ __forceinline__ float bf2f(unsigned short b) { return __builtin_bit_cast(float, (unsigned)b << 16); }
__device__ __forceinline__ float bflo(unsigned w) { return __builtin_bit_cast(float, w << 16); }
__device__ __forceinline__ float bfhi(unsigned w) { return __builtin_bit_cast(float, w & 0xffff0000u); }
__device__ __forceinline__ float dppx1(float x) { return __builtin_bit_cast(float, __builtin_amdgcn_update_dpp(0, __builtin_bit_cast(int, x), 0xB1, 0xF, 0xF, true)); }
__device__ __forceinline__ float dppx2(float x) { return __builtin_bit_cast(float, __builtin_amdgcn_update_dpp(0, __builtin_bit_cast(int, x), 0x4E, 0xF, 0xF, true)); }
__device__ __forceinline__ float bperm(float x, int srclane) { return __builtin_bit_cast(float, __builtin_amdgcn_ds_bpermute(srclane << 2, __builtin_bit_cast(int, x))); }
__device__ __forceinline__ float dpp_hm_(float x) { return __builtin_bit_cast(float, __builtin_amdgcn_update_dpp(0, __builtin_bit_cast(int, x), 0x141, 0xF, 0xF, true)); }
__device__ __forceinline__ float dpp_rm_(float x) { return __builtin_bit_cast(float, __builtin_amdgcn_update_dpp(0, __builtin_bit_cast(int, x), 0x140, 0xF, 0xF, true)); }
__device__ __forceinline__ float wave_sum(float v, int lane) {
    v += dppx1(v); v += dppx2(v); v += dpp_hm_(v); v += dpp_rm_(v);
    v += bperm(v, lane ^ 16); v += bperm(v, lane ^ 32);
    return v;
}
__device__ __forceinline__ float wave_max(float v, int lane) {
    v = fmaxf(v, dppx1(v)); v = fmaxf(v, dppx2(v));
#pragma unroll
    for (int o = 4; o < 64; o <<= 1) v = fmaxf(v, bperm(v, lane ^ o));
    return v;
}
#define LDS_WAIT() asm volatile("s_waitcnt lgkmcnt(0)" ::: "memory")

struct Ctx { int tid, lane, wave, gw, ngw, bid, nblk; LAS unsigned char* lds; };


#define XB_TMO      128
#define XB_XCNT(j)  (256  + 64 * (j))
#define XB_XSUB(j)  (1280 + 64 * (j))
#define XB_XGEN(j)  (2304 + 64 * (j))
#define XB_TOP      3328
#define XB_TOPGEN   3392
#define XCD_BAR_WORDS 3456
#define XB_SPIN_CAP (1u << 23)
__device__ __forceinline__ unsigned xb_ld(unsigned* p)              { return __hip_atomic_load(p, __ATOMIC_RELAXED, __HIP_MEMORY_SCOPE_AGENT); }
__device__ __forceinline__ unsigned xb_add(unsigned* p, unsigned v) { return __hip_atomic_fetch_add(p, v, __ATOMIC_RELAXED, __HIP_MEMORY_SCOPE_AGENT); }
__device__ __forceinline__ unsigned xb_xcc_id() { return (unsigned)__builtin_amdgcn_s_getreg((3 << 11) | 20) & 0xFu; }
#define XB_SPIN(cond, bar) do { unsigned _sp = 0; while (cond) { __builtin_amdgcn_s_sleep(1); \
    if ((++_sp & 255u) == 0u) { if (xb_ld(&(bar)[XB_TMO])) break; if (_sp > XB_SPIN_CAP) { atomicAdd(&(bar)[XB_TMO], 1u); break; } } } } while (0)
__device__ __forceinline__ void xcd_barrier_post(unsigned* bar, int tid) { if (tid == 0) (void)xb_add(&bar[XB_XCNT(xb_xcc_id())], 1u); }
__device__ __forceinline__ void xcd_barrier_complete(unsigned* bar, unsigned x, unsigned G, unsigned& nloc, unsigned& nx) {
    unsigned sum, cnt, mine, sp = 0u;
    for (;;) {
        sum = 0u; cnt = 0u; mine = 0u;
#pragma unroll
        for (unsigned j = 0; j < 16; ++j) { const unsigned c = xb_ld(&bar[XB_XCNT(j)]); sum += c; cnt += (c > 0u) ? 1u : 0u; mine = (j == x) ? c : mine; }
        if (sum == G) break;
        __builtin_amdgcn_s_sleep(1);
        if ((++sp & 255u) == 0u) { if (xb_ld(&bar[XB_TMO])) break; if (sp > XB_SPIN_CAP) { atomicAdd(&bar[XB_TMO], 1u); break; } }
    }
    nloc = mine > 0u ? mine : 1u; nx = cnt > 0u ? cnt : 1u;
}
__device__ __forceinline__ void xcd_barrier(unsigned* bar, volatile LAS unsigned* st, int tid, unsigned G) {
    asm volatile("s_waitcnt vmcnt(0)" ::: "memory");
    __syncthreads();
    if (tid == 0) {
        __builtin_amdgcn_s_waitcnt(0);
        const unsigned x = xb_xcc_id();
        unsigned nloc = st[0], nx = st[1];
        if (nloc == 0u) { xcd_barrier_complete(bar, x, G, nloc, nx); st[0] = nloc; st[1] = nx; }
        const unsigned old = xb_add(&bar[XB_XSUB(x)], 1u);
        const unsigned gen = old / nloc;
        if (old + 1u == (gen + 1u) * nloc) {
            __builtin_amdgcn_fence(__ATOMIC_RELEASE, "agent");
            asm volatile("s_waitcnt vmcnt(0)" ::: "memory");
            const unsigned og = xb_add(&bar[XB_TOP], 1u);
            const unsigned tg = og / nx;
            if (og + 1u == (tg + 1u) * nx) xb_add(&bar[XB_TOPGEN], 1u);
            else XB_SPIN(xb_ld(&bar[XB_TOPGEN]) == tg, bar);
            __builtin_amdgcn_fence(__ATOMIC_ACQUIRE, "agent");
            xb_add(&bar[XB_XGEN(x)], 1u);
            asm volatile("s_waitcnt vmcnt(0)" ::: "memory");
        } else {
            XB_SPIN(xb_ld(&bar[XB_XGEN(x)]) == gen, bar);
            __builtin_amdgcn_fence(__ATOMIC_ACQUIRE, "agent");
            asm volatile("s_waitcnt vmcnt(0)" ::: "memory");
        }
    }
    __syncthreads();
}

__device__ __forceinline__ void transpose_item(const float* W, int K, int ldw, int nblk, bf16* WT, LAS float* scr, int item, int lane, const float* gain = nullptr) {
    const int kb = item / nblk, nb = item % nblk, k0 = 64 * kb, n0 = 32 * nb;
#pragma unroll
    for (int j = 0; j < 8; ++j) { const int kk = (lane >> 3) + 8 * j, nn = (lane & 7) * 4; const float gsc = gain ? gain[k0 + kk] : 1.0f;
        const f32x4 v = *(const f32x4*)(W + (size_t)(k0 + kk) * ldw + n0 + nn); LAS float* d = scr + kk * 33 + nn; d[0] = v.x * gsc; d[1] = v.y * gsc; d[2] = v.z * gsc; d[3] = v.w * gsc; }
    LDS_WAIT(); asm volatile("" ::: "memory");
    const int c = lane & 7;
#pragma unroll
    for (int j = 0; j < 4; ++j) { const int n = (lane >> 3) + 8 * j; const LAS float* s = scr + (8 * c) * 33 + n;
        u32x4 o; o.x = pk2(s[0 * 33], s[1 * 33]); o.y = pk2(s[2 * 33], s[3 * 33]); o.z = pk2(s[4 * 33], s[5 * 33]); o.w = pk2(s[6 * 33], s[7 * 33]);
        *(u32x4*)(WT + (size_t)(n0 + n) * K + k0 + 8 * c) = o; }
    LDS_WAIT(); asm volatile("" ::: "memory");
}
__device__ __forceinline__ void rms_row_to_bf16(const float* xrow, const float* gain, bf16* orow, int lane) {
    const f32x4* xr = (const f32x4*)xrow + lane; const f32x4* gr = (const f32x4*)gain + lane;
    f32x4 v[4]; float s = 0.f;
#pragma unroll
    for (int j = 0; j < 4; ++j) { v[j] = xr[64 * j]; s += (v[j].x * v[j].x + v[j].y * v[j].y) + (v[j].z * v[j].z + v[j].w * v[j].w); }
    const float rs = 1.0f / sqrtf(wave_sum(s, lane) * (1.0f / 1024.0f) + EPS);
    unsigned long long* o8 = (unsigned long long*)orow + lane;
#pragma unroll
    for (int j = 0; j < 4; ++j) { const f32x4 g = gr[64 * j]; o8[64 * j] = (unsigned long long)pk2(v[j].x * rs * g.x, v[j].y * rs * g.y) | ((unsigned long long)pk2(v[j].z * rs * g.z, v[j].w * rs * g.w) << 32); }
}

template <int PART  > __device__ __forceinline__ void convert_weights(const Ctx& c, ArgsP ap, unsigned char* ws, int l) {
    LAS float* scr = (LAS float*)(c.lds + c.wave * 16384);
    const float* w_in = l == 0 ? (const float*)ap->in[4] : (const float*)ap->in[5] + (size_t)(l - 1) * 1024 * IN1;
    const int n_in = l == 0 ? IN0 : IN1;
    const float* w_out = (const float*)ap->in[25] + (size_t)l * 1024 * 1024;
    const float* cwq = (const float*)ap->in[28] + (size_t)l * 1024 * 1024;
    const float* cwkv = (const float*)ap->in[29] + (size_t)l * 1024 * 2048;
    const float* cwo = (const float*)ap->in[30] + (size_t)l * 1024 * 1024;
    const float* wup = (const float*)ap->in[32] + (size_t)l * 1024 * 4096;
    const float* wdn = (const float*)ap->in[33] + (size_t)l * 4096 * 1024;
    const int I_IN = 16 * (n_in / 32), I_SQ = 16 * 32, I_KV = 16 * 64, I_UP = 16 * 128, I_DN = 64 * 32;
    if (PART == 0) {
        for (int it = c.gw; it < I_IN + I_SQ; it += c.ngw) {
            int r = it;
            if (r < I_IN) { transpose_item(w_in, 1024, n_in, n_in / 32, (bf16*)(ws + W_IN), scr, r, c.lane, (const float*)ap->in[3] + l * 1024); continue; } r -= I_IN;
            transpose_item(w_out, 1024, 1024, 32, (bf16*)(ws + W_OUT), scr, r, c.lane);
        }
    } else {
        for (int it = c.gw; it < 2 * I_SQ + I_KV + I_UP + I_DN; it += c.ngw) {
            int r = it;
            if (r < I_SQ) { const f32x4* s4 = (const f32x4*)(cwq + (size_t)r * 2048) + c.lane; u32x2* d2 = (u32x2*)((bf16*)(ws + W_CQ) + (size_t)r * 2048) + c.lane;
#pragma unroll
                for (int j = 0; j < 8; ++j) { const float gsc = ((const float*)ap->in[26])[l * 1024 + 2 * r + (j >> 2)]; const f32x4 v = s4[64 * j] * gsc; u32x2 o; o.x = pk2(v.x, v.y); o.y = pk2(v.z, v.w); d2[64 * j] = o; } continue; } r -= I_SQ;
            if (r < I_SQ) { transpose_item(cwo, 1024, 1024, 32, (bf16*)(ws + W_CO), scr, r, c.lane); continue; } r -= I_SQ;
            if (r < I_KV) { transpose_item(cwkv, 1024, 2048, 64, (bf16*)(ws + W_CKV), scr, r, c.lane); continue; } r -= I_KV;
            if (r < I_UP) { transpose_item(wup, 1024, 4096, 128, (bf16*)(ws + W_UP), scr, r, c.lane, (const float*)ap->in[31] + l * 1024); continue; } r -= I_UP;
            transpose_item(wdn, 4096, 1024, 32, (bf16*)(ws + W_DN), scr, r, c.lane);
        }
        return;
    }
    const int gb = c.gw * 64, ngt = c.ngw * 64;
    const float* wuq = (const float*)ap->in[9] + (size_t)l * 192 * 768;
    const float* wukv = (const float*)ap->in[11] + (size_t)l * 128 * 1024;
    const float* w2 = (const float*)ap->in[14] + (size_t)l * 32 * 512;
    const float* a2 = (const float*)ap->in[16] + (size_t)l * 32 * 512;
    const float* g2 = (const float*)ap->in[17] + (size_t)l * 96 * 512;
    const float* v2 = l > 0 ? (const float*)ap->in[19] + (size_t)(l - 1) * 32 * 512 : nullptr;
    bf16* WUQ = (bf16*)(ws + W_UQ); bf16* WKN = (bf16*)(ws + W_KN); bf16* WVT = (bf16*)(ws + W_VT); bf16* WLR = (bf16*)(ws + W_LR); bf16* WIN = (bf16*)(ws + W_IN);
    for (int eb = gb; eb < 768 * 256; eb += ngt) { const int e = eb + c.lane; const int n = e >> 8, k = e & 255; WUQ[e] = (bf16)(k < 192 ? f2bf(wuq[k * 768 + n]) : 0u); }
    for (int eb = gb; eb < 512 * 128; eb += ngt) { const int e = eb + c.lane; const int n = e >> 7, k = e & 127, h = n >> 6, d = n & 63;
        WKN[e] = (bf16)f2bf(wukv[k * 1024 + h * 128 + d]); WVT[e] = (bf16)f2bf(wukv[k * 1024 + h * 128 + 64 + d]); }
    for (int eb = gb; eb < 2048 * 128; eb += ngt) { const int e = eb + c.lane; const int n = e >> 7, k = e & 127, kind = n >> 9, cc = n & 511; float v = 0.f;
        if (kind == 0) { if (k < 32) v = w2[k * 512 + cc]; }
        else if (kind == 1) { if (k >= 32 && k < 64) v = a2[(k - 32) * 512 + cc]; }
        else if (kind == 2) { if (k < 96) v = g2[k * 512 + cc]; }
        else { if (v2 && k >= 96) v = v2[(k - 96) * 512 + cc]; }
        WLR[e] = (bf16)f2bf(v); }
    for (int eb = gb; eb < (2304 - n_in) * 1024; eb += ngt) WIN[(size_t)n_in * 1024 + eb + c.lane] = 0;
}

__device__ __forceinline__ void prep_pass(const Ctx& c, ArgsP ap, unsigned char* ws, int l) {
    const bf16* __restrict__ proj = (const bf16*)(ws + WS_PROJ); const bf16* __restrict__ proj2 = (const bf16*)(ws + WS_PROJ2);
    bf16* __restrict__ cqn = (bf16*)(ws + WS_CQN); bf16* __restrict__ ckvn = (bf16*)(ws + WS_CKVN); bf16* __restrict__ alr = (bf16*)(ws + WS_ALR); bf16* __restrict__ krope = (bf16*)(ws + WS_KROPE);
    const int* pos = (const int*)ap->in[2];
    const float* qn = (const float*)ap->in[8] + l * 192; const float* kvn = (const float*)ap->in[10] + l * 128;
    const float* mu = l == 0 ? (const float*)ap->in[6] : (const float*)ap->in[7] + (size_t)(l - 1) * 1728;
    const int lane = c.lane;
#pragma unroll 4
    for (int row = c.gw; row < MTOK; row += c.ngw) {
        const bf16* __restrict__ P = proj + (size_t)row * 2048;
        { float v[4] = {0.f, 0.f, 0.f, 0.f}; float ss = 0.f;
          if (lane < 48) { const u32x2 w = *(const u32x2*)(P + 4 * lane); v[0] = bflo(w.x); v[1] = bfhi(w.x); v[2] = bflo(w.y); v[3] = bfhi(w.y); ss = (v[0] * v[0] + v[1] * v[1]) + (v[2] * v[2] + v[3] * v[3]); }
          const float rs = 1.0f / sqrtf(wave_sum(ss, lane) * (1.0f / 192.0f) + EPS);
          u32x2 o; o.x = 0u; o.y = 0u;
          if (lane < 48) { const f32x4 g = *(const f32x4*)(qn + 4 * lane); o.x = pk2(v[0] * rs * g.x, v[1] * rs * g.y); o.y = pk2(v[2] * rs * g.z, v[3] * rs * g.w); }
          *(u32x2*)(cqn + (size_t)row * 256 + 4 * lane) = o; }
        { float v[4] = {0.f, 0.f, 0.f, 0.f}; float ss = 0.f;
          if (lane < 32) { const u32x2 w = *(const u32x2*)(P + 192 + 4 * lane); v[0] = bflo(w.x); v[1] = bfhi(w.x); v[2] = bflo(w.y); v[3] = bfhi(w.y); ss = (v[0] * v[0] + v[1] * v[1]) + (v[2] * v[2] + v[3] * v[3]); }
          const float rs = 1.0f / sqrtf(wave_sum(ss, lane) * (1.0f / 128.0f) + EPS);
          if (lane < 32) { const f32x4 g = *(const f32x4*)(kvn + 4 * lane); u32x2 o; o.x = pk2(v[0] * rs * g.x, v[1] * rs * g.y); o.y = pk2(v[2] * rs * g.z, v[3] * rs * g.w);
              *(u32x2*)(ckvn + (size_t)row * 128 + 4 * lane) = o; } }
        if (lane < 16) { const float x1 = bf2f(P[320 + lane]), x2 = bf2f(P[336 + lane]); float cs, sn; pg8::rope_cs(pos[row], lane, cs, sn);
            krope[(size_t)row * 32 + lane] = (bf16)f2bf(x1 * cs - x2 * sn); krope[(size_t)row * 32 + 16 + lane] = (bf16)f2bf(x1 * sn + x2 * cs); }
        { u32x2 o; o.x = 0u; o.y = 0u;
          const bool has_prev = (row & (SEQ - 1)) != 0;
          if (lane < 40 || (lane < 48 && l > 0)) {
              const bf16* src = lane < 40 ? P + 1888 + 4 * lane : proj2 + (size_t)row * 32 + 4 * (lane - 40);
              const bf16* psrc = lane < 40 ? P - 2048 + 1888 + 4 * lane : proj2 + (size_t)row * 32 - 32 + 4 * (lane - 40);
              const u32x2 w = *(const u32x2*)src; float cur[4] = {bflo(w.x), bfhi(w.x), bflo(w.y), bfhi(w.y)}; float prv[4] = {0.f, 0.f, 0.f, 0.f};
              if (has_prev) { const u32x2 pw = *(const u32x2*)psrc; prv[0] = bflo(pw.x); prv[1] = bfhi(pw.x); prv[2] = bflo(pw.y); prv[3] = bfhi(pw.y); }
              const f32x4 m4 = *(const f32x4*)(mu + 1536 + 4 * lane); const float mm[4] = {m4.x, m4.y, m4.z, m4.w}; float z[4];
#pragma unroll
              for (int j = 0; j < 4; ++j) { z[j] = cur[j] + (prv[j] - cur[j]) * mm[j];
                  if (lane < 8) z[j] = 1.0f - 2.0f / (__expf(2.0f * z[j]) + 1.0f); else if (lane >= 16 && lane < 40) z[j] = pg8::sigmoidf_(z[j]); }
              o.x = pk2(z[0], z[1]); o.y = pk2(z[2], z[3]); }
          *(u32x2*)(alr + (size_t)row * 256 + 4 * lane) = o; }
    }
}


#define MFMA32(a, b, c) __builtin_amdgcn_mfma_f32_32x32x16_bf16((a), (b), (c), 0, 0, 0)
constexpr int AT_KROW = 208, AT_VROW = 144;
constexpr int AT_KBYTES = 64 * AT_KROW, AT_VBYTES = 64 * AT_VROW;
constexpr int AT_BUF = AT_KBYTES + AT_VBYTES;
constexpr int AT_WSF = 2 * AT_BUF;
constexpr int AT_CTRL = AT_WSF + 8 * 256;
__device__ __forceinline__ float max3f(float a, float b, float c) { float r; asm("v_max3_f32 %0, %1, %2, %3" : "=v"(r) : "v"(a), "v"(b), "v"(c)); return r; }
__device__ __forceinline__ int crow(int r, int hi) { return (r & 3) + 8 * (r >> 2) + 4 * hi; }
__device__ __forceinline__ unsigned cvtpk(float lo, float hi) { typedef float f2 __attribute__((ext_vector_type(2))); typedef __bf16 b2 __attribute__((ext_vector_type(2))); f2 v = {lo, hi}; b2 b = __builtin_convertvector(v, b2); return __builtin_bit_cast(unsigned, b); }

__device__ __forceinline__ void mla_attn_unit(const Ctx& c, unsigned char* ws, const float* out_norm, int b, int h, int qb) {
    const int tid = c.tid, lane = c.lane, wid = c.wave, r32 = lane & 31, hi = lane >> 5;
    const bf16* Q = (const bf16*)(ws + WS_Q); const bf16* KN = (const bf16*)(ws + WS_KN); const bf16* KR = (const bf16*)(ws + WS_KROPE); const bf16* VT = (const bf16*)(ws + WS_VT);
    bf16* MIX = (bf16*)(ws + WS_MIX);
    const long rowbase = (long)b * SEQ; const int q0 = qb * 256;
    LAS unsigned char* lds = c.lds;
    LAS float* wsf = (LAS float*)(lds + AT_WSF) + wid * 64;
    bf16x8 qr[6];
    { const bf16* qp = Q + (rowbase + q0 + wid * 32 + r32) * 768 + h * 96 + hi * 8;
#pragma unroll
      for (int s = 0; s < 6; ++s) qr[s] = *(const bf16x8*)(qp + 16 * s); }
    const int nt = 4 * qb + 4;
    const int my_nt = 4 * qb + (wid >> 1) + 1;
    const int krow = tid >> 3, kch = tid & 7;
    const bf16* kn_src = KN + (rowbase + krow) * 512 + h * 64 + kch * 8;
    const bf16* vt_src = VT + ((size_t)((b * 8 + h) * 64) << 12) + krow * 64 + kch * 8;
    const int rrow = (tid & 255) >> 2, rch = tid & 3;
    const bf16* kr_src = KR + (rowbase + rrow) * 32 + rch * 8;
    const int k_dst = krow * AT_KROW + kch * 16, v_dst = AT_KBYTES + krow * AT_VROW + kch * 16, r_dst = rrow * AT_KROW + 128 + rch * 16;
    u32x4 gk, gv, gr;
#define AT_LOAD(t) do { gk = *(const u32x4*)(kn_src + (size_t)(t) * 64 * 512); gv = *(const u32x4*)(vt_src + (size_t)(t) * 4096); if (tid < 256) gr = *(const u32x4*)(kr_src + (size_t)(t) * 64 * 32); } while (0)
#define AT_STORE(bufo) do { *(LAS u32x4*)(lds + (bufo) + k_dst) = gk; *(LAS u32x4*)(lds + (bufo) + v_dst) = gv; if (tid < 256) *(LAS u32x4*)(lds + (bufo) + r_dst) = gr; } while (0)
    float m_run = 0.f, l_run = 0.f;
    f32x16 negm;
#pragma unroll
    for (int i = 0; i < 16; ++i) negm[i] = 0.f;
    f32x16 o0 = {0}, o1 = {0};
#pragma unroll
    for (int i = 0; i < 16; ++i) { o0[i] = 0.f; o1[i] = 0.f; }
    AT_LOAD(0); AT_STORE(0);
    __syncthreads();
    for (int t = 0; t < nt; ++t) {
        const int bufo = (t & 1) * AT_BUF;
        if (t + 1 < nt) AT_LOAD(t + 1);
        if (t < my_nt) {
            const LAS unsigned char* kb = lds + bufo + r32 * AT_KROW + hi * 16;
            f32x16 p0, p1;
            { const bf16x8 a0 = *(const LAS bf16x8*)(kb); const bf16x8 a1 = *(const LAS bf16x8*)(kb + 32 * AT_KROW);
              p0 = MFMA32(a0, qr[0], negm); p1 = MFMA32(a1, qr[0], negm); }
#pragma unroll
            for (int s = 1; s < 6; ++s) {
                const bf16x8 a0 = *(const LAS bf16x8*)(kb + s * 32);
                const bf16x8 a1 = *(const LAS bf16x8*)(kb + 32 * AT_KROW + s * 32);
                p0 = MFMA32(a0, qr[s], p0); p1 = MFMA32(a1, qr[s], p1);
            }
            asm volatile("s_nop 15\n\ts_nop 7" : "+v"(p0), "+v"(p1));
            float mx;
            { float xa = max3f(p0[0], p0[1], p1[0]), xb = max3f(p0[2], p0[3], p1[1]); xa = max3f(xa, p1[2], p1[3]);
#pragma unroll
              for (int r = 4; r < 16; r += 4) { xa = max3f(xa, p0[r], p0[r + 1]); xb = max3f(xb, p0[r + 2], p0[r + 3]); xa = max3f(xa, p1[r], p1[r + 1]); xb = max3f(xb, p1[r + 2], p1[r + 3]); }
              mx = fmaxf(xa, xb); }
            mx = fmaxf(mx, bperm(mx, lane ^ 32));
            const bool first = (t == 0);
            if (first || __builtin_amdgcn_ballot_w64(mx > 0.f) != 0ull) {
                const float dl = first ? mx : fmaxf(mx, 0.f);
                const float alpha = __builtin_amdgcn_exp2f(-dl);
                m_run += dl; l_run *= alpha;
#pragma unroll
                for (int i = 0; i < 16; ++i) { p0[i] -= dl; p1[i] -= dl; negm[i] = -m_run; }
                if (hi == 0) wsf[r32] = alpha;
                LDS_WAIT();
#pragma unroll
                for (int i = 0; i < 16; ++i) { const float f = wsf[crow(i, hi)]; o0[i] *= f; o1[i] *= f; }
            }
            float ps = 0.f;
#pragma unroll
            for (int i = 0; i < 16; ++i) { p0[i] = __builtin_amdgcn_exp2f(p0[i]); p1[i] = __builtin_amdgcn_exp2f(p1[i]); ps += p0[i] + p1[i]; }
            l_run += ps;
            const LAS unsigned char* vb = lds + bufo + AT_KBYTES + r32 * AT_VROW + hi * 8;
#pragma unroll
            for (int half = 0; half < 2; ++half) {
#pragma unroll
                for (int s = 0; s < 2; ++s) {
                    u32x4 pw;
                    if (half == 0) { pw.x = cvtpk(p0[8 * s], p0[8 * s + 1]); pw.y = cvtpk(p0[8 * s + 2], p0[8 * s + 3]); pw.z = cvtpk(p0[8 * s + 4], p0[8 * s + 5]); pw.w = cvtpk(p0[8 * s + 6], p0[8 * s + 7]); }
                    else { pw.x = cvtpk(p1[8 * s], p1[8 * s + 1]); pw.y = cvtpk(p1[8 * s + 2], p1[8 * s + 3]); pw.z = cvtpk(p1[8 * s + 4], p1[8 * s + 5]); pw.w = cvtpk(p1[8 * s + 6], p1[8 * s + 7]); }
                    const bf16x8 pa = __builtin_bit_cast(bf16x8, pw);
                    const int ko = (half * 32 + s * 16) * 2;
                    const s16x4 lo0 = *(const LAS s16x4*)(vb + ko), hi0 = *(const LAS s16x4*)(vb + ko + 16);
                    const s16x4 lo1 = *(const LAS s16x4*)(vb + 32 * AT_VROW + ko), hi1 = *(const LAS s16x4*)(vb + 32 * AT_VROW + ko + 16);
                    const bf16x8 v0 = __builtin_shufflevector(lo0, hi0, 0, 1, 2, 3, 4, 5, 6, 7);
                    const bf16x8 v1 = __builtin_shufflevector(lo1, hi1, 0, 1, 2, 3, 4, 5, 6, 7);
                    o0 = MFMA32(pa, v0, o0); o1 = MFMA32(pa, v1, o1);
                }
            }
        }
        if (t + 1 < nt) AT_STORE(((t + 1) & 1) * AT_BUF);
        __syncthreads();
    }
#undef AT_LOAD
#undef AT_STORE
    l_run += bperm(l_run, lane ^ 32);
    if (hi == 0) wsf[r32] = l_run;
    LDS_WAIT();
    const float g0 = out_norm[h * 64 + r32], g1 = out_norm[h * 64 + 32 + r32];
#pragma unroll
    for (int i = 0; i < 16; ++i) {
        const float il = 1.0f / wsf[crow(i, hi)];
        const float a = o0[i] * il, bb = o1[i] * il;
        float ss = a * a + bb * bb;
        ss += dppx1(ss); ss += dppx2(ss); ss += bperm(ss, lane ^ 4); ss += bperm(ss, lane ^ 8); ss += bperm(ss, lane ^ 16);
        const float rs = 1.0f / sqrtf(ss * (1.0f / 64.0f) + EPS);
        bf16* op = MIX + (rowbase + q0 + wid * 32 + crow(i, hi)) * 1024 + h * 64 + r32;
        op[0] = (bf16)f2bf(a * rs * g0); op[32] = (bf16)f2bf(bb * rs * g1);
    }
    LDS_WAIT();
    __syncthreads();
}

typedef float f32x2 __attribute__((ext_vector_type(2)));
constexpr int SC_T = 32, SC_NCH = SEQ / SC_T;
constexpr int SC_ARR = SC_T * 64 * 4;
constexpr int SC_KK = 0, SC_W = SC_ARR, SC_B = 2 * SC_ARR, SC_K = 3 * SC_ARR, SC_WR = 4 * SC_ARR, SC_V = 5 * SC_ARR, SC_Y = 6 * SC_ARR, SC_SC = 7 * SC_ARR  , SC_BON = SC_SC + SC_T * 8  , SC_BUF = SC_BON + SC_T * 4 + 128;
static_assert(2 * SC_BUF <= 131072, "scan LDS");
__device__ __forceinline__ float dpp_hm(float x) { return __builtin_bit_cast(float, __builtin_amdgcn_update_dpp(0, __builtin_bit_cast(int, x), 0x141, 0xF, 0xF, true)); }
__device__ __forceinline__ float dpp_rm(float x) { return __builtin_bit_cast(float, __builtin_amdgcn_update_dpp(0, __builtin_bit_cast(int, x), 0x140, 0xF, 0xF, true)); }
__device__ __forceinline__ float red8(float v) { v += dppx1(v); v += dppx2(v); v += dpp_hm(v); return v; }
__device__ __forceinline__ float red16(float v) { v += dppx1(v); v += dppx2(v); v += dpp_hm(v); v += dpp_rm(v); return v; }
__device__ __forceinline__ f32x4 unpk4(u32x2 w) { f32x4 r; r.x = bflo(w.x); r.y = bfhi(w.x); r.z = bflo(w.y); r.w = bfhi(w.y); return r; }
__device__ __forceinline__ float hsum4(f32x4 v) { return (v.x + v.y) + (v.z + v.w); }

struct ScanP { const bf16* proj; const bf16* low; bf16* vfirst; bf16* mix; const float* mu; const float* k_k; const float* k_a; const float* r_k; const float* ln_w; const float* ln_b; int layer; };
struct ScanRaw { u32x2 r, k, v, rp, kp, vp, e, a, vg, vf; };
struct ScanC { f32x4 mu_r, mu_k, mu_v, kk_c, ka_c, rk_c, lnw, lnb; };

__device__ __forceinline__ ScanRaw scan_load_raw(const ScanP& p, int chunk, int t, int b, int colb) {
    ScanRaw x; const int s = chunk * SC_T + t; const size_t row = (size_t)b * SEQ + s;
    const bf16* pr = p.proj + row * 2048 + MLA_COLS + colb;
    x.r = *(const u32x2*)pr; x.k = *(const u32x2*)(pr + 512); x.v = *(const u32x2*)(pr + 1024);
    const u32x2 z = {0u, 0u};
    x.rp = z; x.kp = z; x.vp = z;
    if (s > 0) { x.rp = *(const u32x2*)(pr - 2048); x.kp = *(const u32x2*)(pr + 512 - 2048); x.vp = *(const u32x2*)(pr + 1024 - 2048); }
    const bf16* lw = p.low + row * 2048 + colb;
    x.e = *(const u32x2*)lw; x.a = *(const u32x2*)(lw + 512);
    x.vg = z; x.vf = z;
    if (p.layer > 0) { x.vg = *(const u32x2*)(lw + 1536); x.vf = *(const u32x2*)(p.vfirst + row * 512 + colb); }
    return x;
}
__device__ __forceinline__ void scan_stage_write(const ScanP& p, const ScanRaw& x, const ScanC& k, LAS unsigned char* lds, int bufo, int chunk, int t, int b, int colb, int cg) {
    const f32x4 rc = unpk4(x.r), kc = unpk4(x.k), vc = unpk4(x.v), rpv = unpk4(x.rp), kpv = unpk4(x.kp), vpv = unpk4(x.vp);
    const f32x4 r = rc + (rpv - rc) * k.mu_r, kx = kc + (kpv - kc) * k.mu_k; f32x4 v = vc + (vpv - vc) * k.mu_v;
    const f32x4 e = unpk4(x.e), a = unpk4(x.a);
    f32x4 w; w.x = __builtin_amdgcn_exp2f(e.x); w.y = __builtin_amdgcn_exp2f(e.y); w.z = __builtin_amdgcn_exp2f(e.z); w.w = __builtin_amdgcn_exp2f(e.w);
    const int s = chunk * SC_T + t; const size_t row = (size_t)b * SEQ + s;
    if (p.layer == 0) { u32x2 o; o.x = cvtpk(v.x, v.y); o.y = cvtpk(v.z, v.w); *(u32x2*)(p.vfirst + row * 512 + colb) = o; }
    else { const f32x4 vg = unpk4(x.vg), vf = unpk4(x.vf); v = v + (vf - v) * vg; }
    f32x4 kk = kx * k.kk_c; const float n2 = red16(hsum4(kk * kk)); kk = kk * __builtin_amdgcn_rsqf(fmaxf(n2, 1e-24f));
    const f32x4 kmod = kx * (1.0f + (a - 1.0f) * k.ka_c);
    const f32x4 bv = kk * a, wr = w * r;
    const float br = red16(hsum4(bv * r)), kr = red16(hsum4(kmod * r)), bonus = red16(hsum4(r * kmod * k.rk_c));
    LAS unsigned char* base = lds + bufo + t * 256 + cg * 16;
    *(LAS f32x4*)(base + SC_KK) = kk; *(LAS f32x4*)(base + SC_W) = w; *(LAS f32x4*)(base + SC_B) = bv; *(LAS f32x4*)(base + SC_K) = kmod; *(LAS f32x4*)(base + SC_WR) = wr; *(LAS f32x4*)(base + SC_V) = v;
    if (cg == 0) { f32x2 sc; sc.x = br; sc.y = kr; *(LAS f32x2*)(lds + bufo + SC_SC + t * 8) = sc; *(LAS float*)(lds + bufo + SC_BON + t * 4) = bonus; }
}
struct ScanPost { f32x4 y, v; float bonus; };
__device__ __forceinline__ ScanPost scan_post_read(LAS unsigned char* lds, int bufo, int t, int cg) {
    ScanPost q; const LAS unsigned char* base = lds + bufo + t * 256 + cg * 16;
    q.y = *(const LAS f32x4*)(base + SC_Y); q.v = *(const LAS f32x4*)(base + SC_V); q.bonus = *(const LAS float*)(lds + bufo + SC_BON + t * 4); return q;
}
__device__ __forceinline__ void scan_post_finish(const ScanP& p, const ScanPost& q, u32x2 graw, const ScanC& k, int chunk, int t, int b, int colb) {
    const int s = chunk * SC_T + t; const size_t row = (size_t)b * SEQ + s;
    const float mean = red16(hsum4(q.y)) * (1.0f / 64.0f); const f32x4 d = q.y - mean; const float var = red16(hsum4(d * d)) * (1.0f / 64.0f);
    const float rs = __builtin_amdgcn_rsqf(var + GN_EPS);
    const f32x4 g = unpk4(graw);
    const f32x4 yn = (d * rs * k.lnw + k.lnb + q.v * q.bonus) * g;
    u32x2 o; o.x = cvtpk(yn.x, yn.y); o.y = cvtpk(yn.z, yn.w);
    *(u32x2*)(p.mix + row * 1024 + 512 + colb) = o;
}

struct StepIn { f32x4 kk[4], w[4], b[4], k[4], wr[4]; float vv; f32x2 sc; };
__device__ __forceinline__ StepIn scan_ld_step(const LAS unsigned char* bb, int t, int kq, int row) {
    StepIn x; const LAS unsigned char* p = bb + t * 256 + kq * 64;
#pragma unroll
    for (int i = 0; i < 4; ++i) x.kk[i] = *(const LAS f32x4*)(p + SC_KK + 16 * i);
#pragma unroll
    for (int i = 0; i < 4; ++i) x.wr[i] = *(const LAS f32x4*)(p + SC_WR + 16 * i);
#pragma unroll
    for (int i = 0; i < 4; ++i) x.k[i] = *(const LAS f32x4*)(p + SC_K + 16 * i);
#pragma unroll
    for (int i = 0; i < 4; ++i) x.b[i] = *(const LAS f32x4*)(p + SC_B + 16 * i);
#pragma unroll
    for (int i = 0; i < 4; ++i) x.w[i] = *(const LAS f32x4*)(p + SC_W + 16 * i);
    x.vv = *(const LAS float*)(bb + SC_V + t * 256 + row * 4);
    x.sc = *(const LAS f32x2*)(bb + SC_SC + t * 8);
    return x;
}
#define PKFMA(a, b, c) __builtin_elementwise_fma((a), (b), (c))
#define LO2(v) ((f32x2){(v).x, (v).y})
#define HI2(v) ((f32x2){(v).z, (v).w})
__device__ __forceinline__ void scan_do_step(f32x2 (&S)[8], const StepIn& x, LAS unsigned char* bb, int t, int kq, int row) {
    f32x2 sa2 = S[0] * LO2(x.kk[0]), sb2 = S[1] * HI2(x.kk[0]);
    f32x2 ya2 = S[0] * LO2(x.wr[0]), yb2 = S[1] * HI2(x.wr[0]);
#pragma unroll
    for (int i = 1; i < 4; ++i) { sa2 = PKFMA(S[2 * i], LO2(x.kk[i]), sa2); sb2 = PKFMA(S[2 * i + 1], HI2(x.kk[i]), sb2); ya2 = PKFMA(S[2 * i], LO2(x.wr[i]), ya2); yb2 = PKFMA(S[2 * i + 1], HI2(x.wr[i]), yb2); }
    sa2 = sa2 + sb2; ya2 = ya2 + yb2;
    float sa = sa2.x + sa2.y, yv = ya2.x + ya2.y;
    sa += dppx1(sa); yv += dppx1(yv); sa += dppx2(sa); yv += dppx2(yv);
    sa = -sa;
    const float yo = yv + sa * x.sc.x + x.vv * x.sc.y;
    const f32x2 sav = {sa, sa}, vvv = {x.vv, x.vv};
#pragma unroll
    for (int i = 0; i < 4; ++i) {
        f32x2 t0 = vvv * LO2(x.k[i]), t1 = vvv * HI2(x.k[i]);
        t0 = PKFMA(sav, LO2(x.b[i]), t0); t1 = PKFMA(sav, HI2(x.b[i]), t1);
        S[2 * i] = PKFMA(S[2 * i], LO2(x.w[i]), t0); S[2 * i + 1] = PKFMA(S[2 * i + 1], HI2(x.w[i]), t1);
    }
    if (kq == 0) *(LAS float*)(bb + SC_Y + t * 256 + row * 4) = yo;
}

__device__ __forceinline__ void scan_unit(const Ctx& c, const ScanP& p, int b, int h) {
    LAS unsigned char* lds = c.lds; const int lane = c.lane, wid = c.wave;
    if (wid >= 4) {
        const int sw = wid - 4, tq = lane >> 4, cg = lane & 15, colb = h * 64 + 4 * cg;
        ScanC k; k.mu_r = *(const f32x4*)(p.mu + colb); k.mu_k = *(const f32x4*)(p.mu + 512 + colb); k.mu_v = *(const f32x4*)(p.mu + 1024 + colb);
        k.kk_c = *(const f32x4*)(p.k_k + colb); k.ka_c = *(const f32x4*)(p.k_a + colb); k.rk_c = *(const f32x4*)(p.r_k + colb); k.lnw = *(const f32x4*)(p.ln_w + colb); k.lnb = *(const f32x4*)(p.ln_b + colb);
        const int t0 = 8 * sw + tq, t1 = t0 + 4;
        { const ScanRaw a0 = scan_load_raw(p, 0, t0, b, colb), a1 = scan_load_raw(p, 0, t1, b, colb);
          scan_stage_write(p, a0, k, lds, 0, 0, t0, b, colb, cg); scan_stage_write(p, a1, k, lds, 0, 0, t1, b, colb, cg); }
        ScanRaw c0 = scan_load_raw(p, 1, t0, b, colb), c1 = scan_load_raw(p, 1, t1, b, colb);
        for (int ch = 0; ch < SC_NCH; ++ch) {
            __syncthreads();
            ScanRaw n0 = c0, n1 = c1;
            if (ch + 2 < SC_NCH) { n0 = scan_load_raw(p, ch + 2, t0, b, colb); n1 = scan_load_raw(p, ch + 2, t1, b, colb); }
            u32x2 g0 = {0u, 0u}, g1 = {0u, 0u}; ScanPost q0, q1;
            if (ch >= 1) {
                const size_t rowp = (size_t)b * SEQ + (ch - 1) * SC_T;
                g0 = *(const u32x2*)(p.low + (rowp + t0) * 2048 + 1024 + colb); g1 = *(const u32x2*)(p.low + (rowp + t1) * 2048 + 1024 + colb);
                q0 = scan_post_read(lds, ((ch - 1) & 1) * SC_BUF, t0, cg); q1 = scan_post_read(lds, ((ch - 1) & 1) * SC_BUF, t1, cg);
            }
            if (ch + 1 < SC_NCH) { scan_stage_write(p, c0, k, lds, ((ch + 1) & 1) * SC_BUF, ch + 1, t0, b, colb, cg); scan_stage_write(p, c1, k, lds, ((ch + 1) & 1) * SC_BUF, ch + 1, t1, b, colb, cg); }
            if (ch >= 1) { scan_post_finish(p, q0, g0, k, ch - 1, t0, b, colb); scan_post_finish(p, q1, g1, k, ch - 1, t1, b, colb); }
            c0 = n0; c1 = n1;
        }
        __syncthreads();
        { const size_t rowp = (size_t)b * SEQ + (SC_NCH - 1) * SC_T; const int bo = ((SC_NCH - 1) & 1) * SC_BUF;
          const u32x2 g0 = *(const u32x2*)(p.low + (rowp + t0) * 2048 + 1024 + colb), g1 = *(const u32x2*)(p.low + (rowp + t1) * 2048 + 1024 + colb);
          const ScanPost q0 = scan_post_read(lds, bo, t0, cg), q1 = scan_post_read(lds, bo, t1, cg);
          scan_post_finish(p, q0, g0, k, SC_NCH - 1, t0, b, colb); scan_post_finish(p, q1, g1, k, SC_NCH - 1, t1, b, colb); }
    } else {
        const int kq = lane & 3, r0 = wid * 16 + (lane >> 2);
        f32x2 S[8];
#pragma unroll
        for (int i = 0; i < 8; ++i) { S[i].x = 0.f; S[i].y = 0.f; }
        for (int ch = 0; ch < SC_NCH; ++ch) {
            __syncthreads();
            LAS unsigned char* bb = lds + (ch & 1) * SC_BUF;
            StepIn A = scan_ld_step(bb, 0, kq, r0), B;
#pragma unroll
            for (int t = 0; t < SC_T; t += 2) {
                B = scan_ld_step(bb, t + 1, kq, r0);
                scan_do_step(S, A, bb, t, kq, r0);
                if (t + 2 < SC_T) A = scan_ld_step(bb, t + 2, kq, r0);
                scan_do_step(S, B, bb, t + 1, kq, r0);
            }
        }
        __syncthreads();
    }
    __syncthreads();
}

#define GEMM_PHASE_ROT_A(EpiT, g, e, rot, ALIGN) do { NEWCTX(); pg8::StaticOrder S_; S_.init((g).M, (g).N, c.nblk, (c.bid + c.nblk - (rot)) % c.nblk); pg8::gemm_phase<EpiT, pg8::StaticOrder, ALIGN, true>(c.lds, (g), S_, (e), c.tid); } while (0)
#define GEMM_PHASE_ROT(EpiT, g, e, rot) GEMM_PHASE_ROT_A(EpiT, g, e, rot, true)
#define GEMM_PHASE(EpiT, g, e) GEMM_PHASE_ROT(EpiT, g, e, 0)

typedef pg8::EpiResidual<true, false> EPI_T0; typedef pg8::EpiResidual<false, false> EPI_T1;
__global__ void __launch_bounds__(NTHREADS, 2) fwd_megakernel(Args a_unused) {
    extern __shared__ __attribute__((aligned(16))) unsigned char lds_raw[];
    cg::grid_group grid = cg::this_grid();
    Ctx c;
    const int wave_s = __builtin_amdgcn_readfirstlane((int)threadIdx.x >> 6);
    ArgsP ap; unsigned char* ws; float* hout; const float* xin; bf16* XN; unsigned* ctl;
#define NEWCTX() do { int l_; asm volatile("v_mbcnt_lo_u32_b32 %0, -1, 0\n\tv_mbcnt_hi_u32_b32 %0, -1, %0" : "=v"(l_)); \
        ap = (ArgsP)__builtin_amdgcn_kernarg_segment_ptr(); asm volatile("" : "+s"(ap)); \
        { int b_ = blockIdx.x, n_ = gridDim.x, w_ = wave_s; asm volatile("" : "+s"(b_), "+s"(n_), "+s"(w_)); c.bid = b_; c.nblk = n_; c.wave = w_; } \
        c.lane = l_; c.tid = c.wave * 64 + l_; c.gw = c.bid * NWAVES + c.wave; c.ngw = c.nblk * NWAVES; c.lds = (LAS unsigned char*)lds_raw; \
        ws = ap->ws; hout = ap->out; xin = (const float*)ap->in[0]; XN = (bf16*)hout;     ctl = (unsigned*)(ws + WS_CTL); } while (0)
    NEWCTX();
    volatile LAS unsigned* bar_st = (volatile LAS unsigned*)(lds_raw + 131072 + 64);
    if (c.tid < 2) bar_st[c.tid] = 0u;
    __syncthreads();
    xcd_barrier_post((unsigned*)(ws + WS_CTL + CTL_BAR), c.tid);
#define SYNC() do { NEWCTX(); xcd_barrier((unsigned*)(ws + WS_CTL + CTL_BAR), bar_st, c.tid, (unsigned)c.nblk); NEWCTX(); } while (0)
#define SS(i) ((float*)(ws + WS_SSP))

    { const float* mem = (const float*)ap->in[1]; const float* mg = (const float*)ap->in[27]; bf16* memn = (bf16*)(ws + WS_MEMN);
      for (int row = c.gw; row < MMEM; row += c.ngw) rms_row_to_bf16(mem + (size_t)row * 1024, mg, memn + (size_t)row * 1024, c.lane); }
    { float* __restrict__ ss0 = SS(0);
#pragma unroll 4
      for (int row = c.gw; row < MTOK; row += c.ngw) {
          const f32x4* __restrict__ xr = (const f32x4*)(xin + (size_t)row * 1024) + c.lane; unsigned long long* __restrict__ o8 = (unsigned long long*)(XN + (size_t)row * 1024) + c.lane;
          float s = 0.f;
#pragma unroll
          for (int j = 0; j < 4; ++j) { const f32x4 v = xr[64 * j]; s += (v.x * v.x + v.y * v.y) + (v.z * v.z + v.w * v.w);
              o8[64 * j] = (unsigned long long)pk2(v.x, v.y) | ((unsigned long long)pk2(v.z, v.w) << 32); }
          s = wave_sum(s, c.lane);
          if (c.lane < 16) ss0[(size_t)row * 16 + c.lane] = c.lane == 0 ? s : 0.f;
      } }
    convert_weights<0>(c, ap, ws, 0);
    grid.sync(); NEWCTX();

    for (int l = 0; l < DEPTH; ++l) {
        { pg8::Gemm g = pg8::mk_gemm(XN, (const bf16*)(ws + W_IN), MTOK, l == 0 ? 2048 : 2304, 1024);
          pg8::EpiBf16<0> e = pg8::mk_epi_bf16((bf16*)(ws + WS_PROJ), 2048, 1.0f); e.c2_lo = 2048; e.c2_hi = 2080; e.O2 = (bf16*)(ws + WS_PROJ2); e.ldc2 = 32; e.ss = SS(3 * l);
          GEMM_PHASE(pg8::EpiBf16<0>, g, e); }
        SYNC();
        prep_pass(c, ap, ws, l);
        convert_weights<1>(c, ap, ws, l);
        SYNC();
        { pg8::Gemm g = pg8::mk_gemm((const bf16*)(ws + WS_CQN), (const bf16*)(ws + W_UQ), MTOK, 768, 256);
          pg8::EpiQRope e; e.O = (bf16*)(ws + WS_Q); e.pos = (const int*)ap->in[2]; e.scale = MLA_QSCALE; GEMM_PHASE(pg8::EpiQRope, g, e); }
        { pg8::Gemm g = pg8::mk_gemm((const bf16*)(ws + WS_CKVN), (const bf16*)(ws + W_KN), MTOK, 512, 128);
          pg8::EpiBf16<0> e = pg8::mk_epi_bf16((bf16*)(ws + WS_KN), 512, 1.0f); GEMM_PHASE(pg8::EpiBf16<0>, g, e); }
        { pg8::Gemm g = pg8::mk_gemm((const bf16*)(ws + W_VT), (const bf16*)(ws + WS_CKVN), 512, MTOK, 128);
          pg8::EpiVT e; e.O = (bf16*)(ws + WS_VT); GEMM_PHASE(pg8::EpiVT, g, e); }
        { pg8::Gemm g = pg8::mk_gemm((const bf16*)(ws + WS_ALR), (const bf16*)(ws + W_LR), MTOK, l == 0 ? 1536 : 2048, 128); g.lda = 256; g.a_lo = (long)512 * 256; g.a_sh = 2; g.a_pn2 = 128;
          pg8::EpiLowrank e; e.O = (bf16*)(ws + WS_LOW); e.w0 = (const float*)ap->in[13] + l * 512; e.a0 = (const float*)ap->in[15] + l * 512; e.v0 = l > 0 ? (const float*)ap->in[18] + (l - 1) * 512 : (const float*)ap->in[15];
          GEMM_PHASE(pg8::EpiLowrank, g, e); }
        { pg8::Gemm g = pg8::mk_gemm((const bf16*)(ws + WS_MEMN), (const bf16*)(ws + W_CKV), MMEM, 2048, 1024);
          pg8::EpiBf16<0> e = pg8::mk_epi_bf16((bf16*)(ws + WS_MEMKV), 2048, 1.0f); GEMM_PHASE_ROT(pg8::EpiBf16<0>, g, e, 128); }
        SYNC();
        if (c.bid < 128) {
            ScanP p; p.proj = (const bf16*)(ws + WS_PROJ); p.low = (const bf16*)(ws + WS_LOW); p.vfirst = (bf16*)(ws + WS_VFIRST); p.mix = (bf16*)(ws + WS_MIX);
            p.mu = l == 0 ? (const float*)ap->in[6] : (const float*)ap->in[7] + (size_t)(l - 1) * 1728;
            p.k_k = (const float*)ap->in[20] + l * 512; p.k_a = (const float*)ap->in[21] + l * 512; p.r_k = (const float*)ap->in[22] + l * 512;
            p.ln_w = (const float*)ap->in[23] + l * 512; p.ln_b = (const float*)ap->in[24] + l * 512; p.layer = l;
            scan_unit(c, p, c.bid >> 3, c.bid & 7);
        }
        { const float* onorm = (const float*)ap->in[12] + l * 512; LAS unsigned* uw = (LAS unsigned*)(c.lds + AT_CTRL);
          for (;;) {
              if (c.tid == 0) *uw = atomicAdd(ctl + 64 * l, 1u);
              __syncthreads();
              const unsigned u = *uw;
              __syncthreads();
              if (u >= 2048u) break;
              const int qb = 15 - (int)(u >> 7), bh = (int)(u & 127);
              mla_attn_unit(c, ws, onorm, bh >> 3, bh & 7, qb);
          } }
        SYNC();
        { pg8::Gemm g = pg8::mk_gemm((const bf16*)(ws + WS_MIX), (const bf16*)(ws + W_OUT), MTOK, 1024, 1024);
          if (l == 0) { pg8::EpiResidual<true, false> e; e.basef = xin; e.baseh = XN; e.outf = nullptr; e.outh = XN; e.ss = SS(1); GEMM_PHASE(EPI_T0, g, e); }
          else { pg8::EpiResidual<false, false> e; e.basef = nullptr; e.baseh = XN; e.outf = nullptr; e.outh = XN; e.ss = SS(3 * l + 1); GEMM_PHASE(EPI_T1, g, e); } }
        { pg8::Gemm g = pg8::mk_gemm((const bf16*)(ws + WS_MEMKV), (const bf16*)(ws + W_CQ), 64 * 256, 1024, 256); g.lda = 2048; g.ldb = 1024;
          g.a_d = 4; g.a_hi = (long)256 * 2048 * 2; g.a_lo = 512; g.b_pn = (long)256 * 1024 * 2; g.b_pmod = 4; g.b_pmo = 512;
          pg8::EpiBf16<0> e = pg8::mk_epi_bf16((bf16*)(ws + WS_WKT), 1024, 1.0f); GEMM_PHASE(pg8::EpiBf16<0>, g, e); }
        { pg8::Gemm g = pg8::mk_gemm((const bf16*)(ws + W_CO), (const bf16*)(ws + WS_MEMKV) + 1024, 64 * 256, 1024, 256); g.lda = 1024; g.ldb = 2048;
          g.a_d = 4; g.a_hi = 0; g.a_lo = (long)256 * 1024 * 2; g.a_pn = 512; g.b_pn = 512; g.tpb = 4; g.b_bt = (long)256 * 2048 * 2;
          pg8::EpiBf16<0> e = pg8::mk_epi_bf16((bf16*)(ws + WS_VWT), 1024, 1.0f); GEMM_PHASE(pg8::EpiBf16<0>, g, e); }
        SYNC();
        { pg8::Gemm g = pg8::mk_gemm(XN, (const bf16*)(ws + WS_WKT), MTOK, 1024, 1024); g.tpb = 16; g.b_bt = (long)1024 * 1024 * 2;
          pg8::EpiSoftmax e; e.P = (bf16*)(ws + WS_P); e.xm = (LAS float*)(c.lds + 131072 + 1024); e.xs = (LAS float*)(c.lds + 131072 + 1024 + 4096); e.ss = SS(3 * l + 1); e.scale = CA_QSCALE;
          GEMM_PHASE(pg8::EpiSoftmax, g, e); }
        SYNC();
        { pg8::Gemm g = pg8::mk_gemm((const bf16*)(ws + WS_P), (const bf16*)(ws + WS_VWT), MTOK, 1024, 1024); g.tpb = 16; g.b_bt = (long)1024 * 1024 * 2;
          pg8::EpiResidual<false, false> e; e.basef = nullptr; e.baseh = XN; e.outf = nullptr; e.outh = XN; e.ss = SS(3 * l + 2); GEMM_PHASE(EPI_T1, g, e); }
        SYNC();
        if (l + 1 < DEPTH) convert_weights<0>(c, ap, ws, l + 1);
        LDS_WAIT(); __syncthreads();
        { pg8::Gemm g = pg8::mk_gemm(XN, (const bf16*)(ws + W_UP), MTOK, DFF, 1024);
          pg8::EpiBf16<1> e; e.O = (bf16*)(ws + WS_HID); e.ldc = DFF; e.scale = 1.0f; e.c2_lo = 1 << 30; e.c2_hi = 1 << 30; e.O2 = e.O; e.ldc2 = 0; e.nt = 1; e.ss = SS(3 * l + 2); GEMM_PHASE(pg8::EpiBf16<1>, g, e); }
        SYNC();
        { pg8::Gemm g = pg8::mk_gemm((const bf16*)(ws + WS_HID), (const bf16*)(ws + W_DN), MTOK, 1024, DFF);
          pg8::EpiResidual<false, false> e; e.basef = nullptr; e.baseh = XN; e.outf = nullptr; e.outh = l + 1 < DEPTH ? XN : (bf16*)(ws + WS_HF32); e.ss = SS(3 * l + 3); GEMM_PHASE(EPI_T1, g, e); }
        SYNC();
    }
    { const float* g = (const float*)ap->in[34]; const float* ssf = SS(3 * DEPTH); const bf16* hf = (const bf16*)(ws + WS_HF32);
#pragma unroll 4
      for (int row = c.gw; row < MTOK; row += c.ngw) {
          const u32x2* __restrict__ xr = (const u32x2*)(hf + (size_t)row * 1024) + c.lane; f32x4* __restrict__ orow = (f32x4*)(hout + (size_t)row * 1024) + c.lane; const f32x4* __restrict__ gr = (const f32x4*)g + c.lane;
          float sp = c.lane < 16 ? ssf[(size_t)row * 16 + c.lane] : 0.f; sp = wave_sum(sp, c.lane);
          const float rs = 1.0f / sqrtf(sp * (1.0f / 1024.0f) + EPS);
#pragma unroll
          for (int j = 0; j < 4; ++j) { const u32x2 w = xr[64 * j]; f32x4 v; v.x = bflo(w.x); v.y = bfhi(w.x); v.z = bflo(w.y); v.w = bfhi(w.y); orow[64 * j] = v * rs * gr[64 * j]; }
      } }
}

extern "C" void kernel_launch(void* const* d_in, const int* in_sizes, int n_in, void* d_out, int out_size, void* d_ws, size_t ws_size, hipStream_t stream) {
    static int grid = 0;
    if (grid == 0) {
        if (n_in != 35 || out_size != MTOK * DM || ws_size < WS_NEED) { fprintf(stderr, "kernel_launch: unexpected shapes (n_in %d out %d ws %zu)\n", n_in, out_size, ws_size); grid = -1; return; }
        int dev = 0, cus = 0, per_cu = 0;
        hipGetDevice(&dev); hipDeviceGetAttribute(&cus, hipDeviceAttributeMultiprocessorCount, dev);
        hipFuncSetAttribute((const void*)fwd_megakernel, hipFuncAttributeMaxDynamicSharedMemorySize, LDS_BYTES);
        hipOccupancyMaxActiveBlocksPerMultiprocessor(&per_cu, (const void*)fwd_megakernel, NTHREADS, LDS_BYTES);
        (void)hipGetLastError();
        if (per_cu < 1) per_cu = 1;
        grid = cus * 1;
        if (grid < 128) { fprintf(stderr, "kernel_launch: grid %d too small\n", grid); grid = -1; return; }
    }
    if (grid < 0) return;
    hipMemsetAsync((char*)d_ws + WS_CTL, 0, CTL_BYTES, stream);
    Args a{};
    for (int i = 0; i < 35; ++i) a.in[i] = d_in[i];
    a.out = (float*)d_out; a.ws = (unsigned char*)d_ws;
    void* params[] = {&a};
    hipError_t e = hipLaunchCooperativeKernel((const void*)fwd_megakernel, dim3(grid), dim3(NTHREADS), params, LDS_BYTES, stream);
    if (e != hipSuccess) fprintf(stderr, "cooperative launch failed: %s (grid %d)\n", hipGetErrorString(e), grid);
}
```
